# Optimizing an MI355X kernel written in HIP

```python
import math
import jax, jax.numpy as jnp
from jax import lax
import numpy as np

D_MODEL = 1024
BATCH = 16
SEQ = 256
DEPTH = 4
DEC_BATCH = 4
DEC_SEQ = 1024
PAST_LEN = 512

GRID_W = 64
MIX_W = D_MODEL
N_MIXERS = 3
QBLK = 128
ROPE_BASE = 10000.0
NORM_EPS = 1e-6
HQ_A = 16
HKV_A = 4
G_A = HQ_A // HKV_A
DH_A = MIX_W // HQ_A
WINDOW = 128
WBLK = WINDOW
H_B = 8
DH_B = MIX_W // (2 * H_B)
H_C = 8
DK_C = MIX_W // H_C
DV_C = MIX_W // H_C
CONV_K = 3
CHUNK = 64
IN_A = HQ_A * DH_A + 2 * HKV_A * DH_A + MIX_W
IN_B = 4 * MIX_W
IN_C = 4 * MIX_W + 4 * H_C

kernel_name = "hybrid_diffusion_prefix_trunk_step"

F32 = jnp.float32


def rmsnorm(x, w):
    xf = x.astype(F32)
    y = xf * lax.rsqrt(jnp.mean(xf * xf, axis=-1, keepdims=True) + NORM_EPS)
    return (y * w.astype(F32)).astype(x.dtype)


def l2norm(x):
    xf = x.astype(F32)
    return (xf * lax.rsqrt(jnp.sum(xf * xf, axis=-1, keepdims=True) + 1e-6)).astype(x.dtype)


def ada_modulate(x, norm_w, mod_w, mod_b, cond):
    m = jax.nn.silu(cond) @ mod_w + mod_b
    shift, scale, gate = jnp.split(m, 3, axis=-1)
    h = rmsnorm(x, norm_w) * (1 + scale[:, None, :]) + shift[:, None, :]
    return h, gate[:, None, :]


def axial_angles(n, dh):
    rows = n // GRID_W
    row = jnp.repeat(jnp.arange(rows), GRID_W).astype(F32)
    col = jnp.tile(jnp.arange(GRID_W), rows).astype(F32)
    quarter = dh // 4
    inv = ROPE_BASE ** (-jnp.arange(quarter, dtype=F32) / quarter)
    return row[:, None] * inv, col[:, None] * inv


def rope_1d(x, ang):
    d2 = x.shape[-1] // 2
    cos = jnp.cos(ang)[None, :, None, :].astype(x.dtype)
    sin = jnp.sin(ang)[None, :, None, :].astype(x.dtype)
    x1, x2 = x[..., :d2], x[..., d2:]
    return jnp.concatenate([x1 * cos - x2 * sin, x2 * cos + x1 * sin], axis=-1)


def axial_rope(x, ang_row, ang_col):
    h = x.shape[-1] // 2
    return jnp.concatenate([rope_1d(x[..., :h], ang_row), rope_1d(x[..., h:], ang_col)], axis=-1)


def query_blocks(fn, q):
    b, n = q.shape[:2]
    qb = jnp.moveaxis(q.reshape((b, n // QBLK, QBLK) + q.shape[2:]), 1, 0)
    o = jnp.moveaxis(lax.map(fn, qb), 0, 1)
    return o.reshape((b, n) + o.shape[3:])


def sink_softmax(s, sink):
    m = jnp.maximum(jnp.max(s, axis=-1, keepdims=True), sink)
    e = jnp.exp(s - m)
    return e / (jnp.sum(e, axis=-1, keepdims=True) + jnp.exp(sink - m))


def sink_attention(q, k, v, sink):
    scale = DH_A ** -0.5
    sk = sink.astype(F32).reshape(1, HKV_A, G_A, 1, 1)

    def block(qb):
        b, nq = qb.shape[:2]
        qg = qb.reshape(b, nq, HKV_A, G_A, DH_A)
        s = jnp.einsum('bqhgd,bkhd->bhgqk', qg, k).astype(F32) * scale
        p = sink_softmax(s, sk).astype(v.dtype)
        return jnp.einsum('bhgqk,bkhd->bqhgd', p, v).reshape(b, nq, HQ_A, DH_A)

    return query_blocks(block, q)


def banded_window_attention(q, k, v, kc, vc, sink):
    b, n = q.shape[:2]
    nb = n // WBLK
    scale = DH_A ** -0.5
    qb = q.reshape(b, nb, WBLK, HKV_A, G_A, DH_A)
    pad = ((0, 0), (WBLK, WBLK), (0, 0), (0, 0))
    kp = jnp.pad(k, pad).reshape(b, nb + 2, WBLK, HKV_A, DH_A)
    vp = jnp.pad(v, pad).reshape(b, nb + 2, WBLK, HKV_A, DH_A)
    kw = jnp.concatenate([kp[:, :-2], kp[:, 1:-1], kp[:, 2:]], axis=2)
    vw = jnp.concatenate([vp[:, :-2], vp[:, 1:-1], vp[:, 2:]], axis=2)
    blk = jnp.arange(nb)[:, None, None]
    qi = blk * WBLK + jnp.arange(WBLK)[None, :, None]
    kj = (blk - 1) * WBLK + jnp.arange(3 * WBLK)[None, None, :]
    valid = (jnp.abs(kj - qi) <= WINDOW) & (kj >= 0) & (kj < n)
    s_loc = jnp.einsum('bnqhgd,bnkhd->bnhgqk', qb, kw).astype(F32) * scale
    s_loc = jnp.where(valid[None, :, None, None, :, :], s_loc, -jnp.inf)
    s_ctx = jnp.einsum('bnqhgd,bchd->bnhgqc', qb, kc).astype(F32) * scale
    s = jnp.concatenate([s_loc, s_ctx], axis=-1)
    p = sink_softmax(s, sink.astype(F32).reshape(1, 1, HKV_A, G_A, 1, 1)).astype(v.dtype)
    o = (jnp.einsum('bnhgqk,bnkhd->bnqhgd', p[..., :3 * WBLK], vw)
         + jnp.einsum('bnhgqc,bchd->bnqhgd', p[..., 3 * WBLK:], vc))
    return o.reshape(b, n, HQ_A, DH_A)


def mixer_a_project(h, in_w):
    b, n, _ = h.shape
    pr = h @ in_w
    nq, nkv = HQ_A * DH_A, HKV_A * DH_A
    q = pr[..., :nq].reshape(b, n, HQ_A, DH_A)
    k = pr[..., nq:nq + nkv].reshape(b, n, HKV_A, DH_A)
    v = pr[..., nq + nkv:nq + 2 * nkv].reshape(b, n, HKV_A, DH_A)
    z = pr[..., nq + 2 * nkv:]
    return q, k, v, z


def mixer_a_context(h, p):
    b, n, _ = h.shape
    q, k, v, z = mixer_a_project(h, p["in_w"])
    o = sink_attention(q, k, v, p["sink"])
    out = (o.reshape(b, n, MIX_W) * jax.nn.silu(z)) @ p["out_w"]
    return out, k, v


def mixer_a_latent(h, p, kc, vc):
    b, n, _ = h.shape
    q, k, v, z = mixer_a_project(h, p["in_w"])
    ar, ac = axial_angles(n, DH_A)
    q = axial_rope(q, ar, ac)
    k = axial_rope(k, ar, ac)
    o = banded_window_attention(q, k, v, kc, vc, p["sink"])
    return (o.reshape(b, n, MIX_W) * jax.nn.silu(z)) @ p["out_w"]


def mixer_b_project(h, in_w):
    b, n, _ = h.shape
    pr = h @ in_w
    q = pr[..., :MIX_W].reshape(b, n, H_B, 2, DH_B)
    k = pr[..., MIX_W:2 * MIX_W].reshape(b, n, H_B, 2, DH_B)
    v = pr[..., 2 * MIX_W:3 * MIX_W].reshape(b, n, H_B, 2 * DH_B)
    z = pr[..., 3 * MIX_W:]
    return q, k, v, z


def diff_lambda(p, lam_init):
    dot_exp = lambda a, c: jnp.exp(jnp.sum(a.astype(F32) * c.astype(F32)))
    return dot_exp(p["lq1"], p["lk1"]) - dot_exp(p["lq2"], p["lk2"]) + lam_init


def diff_attention(q, k, v, lam):
    scale = DH_B ** -0.5

    def block(qb):
        s = jnp.einsum('bqhcd,bkhcd->bhcqk', qb, k).astype(F32) * scale
        pr = jax.nn.softmax(s, axis=-1)
        a = (pr[:, :, 0] - lam * pr[:, :, 1]).astype(v.dtype)
        return jnp.einsum('bhqk,bkhe->bqhe', a, v)

    return query_blocks(block, q)


def mixer_b_out(o, z, p, lam_init):
    b, n = o.shape[:2]
    o = rmsnorm(o, p["subln_w"]) * (1.0 - lam_init)
    return (o.reshape(b, n, MIX_W) * jax.nn.silu(z)) @ p["out_w"]


def mixer_b_context(h, p, lam_init):
    q, k, v, z = mixer_b_project(h, p["in_w"])
    o = diff_attention(q, k, v, diff_lambda(p, lam_init))
    return mixer_b_out(o, z, p, lam_init), k, v


def mixer_b_latent(h, p, lam_init, kc, vc):
    b, n, _ = h.shape
    q, k, v, z = mixer_b_project(h, p["in_w"])
    ar, ac = axial_angles(n, DH_B)
    rot = lambda t: axial_rope(t.reshape(b, n, 2 * H_B, DH_B), ar, ac).reshape(b, n, H_B, 2, DH_B)
    q, k = rot(q), rot(k)
    k_all = jnp.concatenate([k, kc], axis=1)
    v_all = jnp.concatenate([v, vc], axis=1)
    o = diff_attention(q, k_all, v_all, diff_lambda(p, lam_init))
    return mixer_b_out(o, z, p, lam_init)


def depthwise_conv_centred(x, w):
    ch = x.shape[-1]
    return lax.conv_general_dilated(
        x, w[:, None, :], window_strides=(1,), padding=((CONV_K // 2, CONV_K // 2),),
        dimension_numbers=('NWC', 'WIO', 'NWC'), feature_group_count=ch)


def gated_delta_chunked(q, k, v, g, beta, s0):
    dt = v.dtype
    q, k, v, g, beta, s0 = (t.astype(F32) for t in (q, k, v, g, beta, s0))
    b, n, h, dk = q.shape
    dv = v.shape[-1]
    nc = n // CHUNK

    def to_chunks(t):
        t = t.reshape((b, nc, CHUNK, h) + t.shape[3:])
        return jnp.moveaxis(jnp.moveaxis(t, 1, 0), 2, 3)

    qc, kc, vc, gc, bc = (to_chunks(t) for t in (q, k, v, g, beta))
    gcum = jnp.cumsum(gc, axis=-1)
    idx = jnp.arange(CHUNK)
    incl = idx[:, None] >= idx[None, :]
    strict = idx[:, None] > idx[None, :]
    decay = jnp.exp(jnp.where(incl, gcum[..., :, None] - gcum[..., None, :], -jnp.inf))
    kb = kc * bc[..., None]
    lmat = jnp.where(strict, jnp.einsum('...id,...jd->...ij', kb, kc) * decay, 0.0)
    eye = jnp.eye(CHUNK, dtype=F32)
    rhs = jnp.concatenate([vc * bc[..., None], kb * jnp.exp(gcum)[..., None]], axis=-1)
    sol = lax.linalg.triangular_solve(eye + lmat, rhs, left_side=True, lower=True)
    u, w = sol[..., :dv], sol[..., dv:]

    def step(state, inp):
        qi, ki, ui, wi, gi, di = inp
        intra = jnp.where(incl, jnp.einsum('bhid,bhjd->bhij', qi, ki) * di, 0.0)
        vnew = ui - jnp.einsum('bhck,bhkv->bhcv', wi, state)
        o = (jnp.einsum('bhck,bhkv->bhcv', qi * jnp.exp(gi)[..., None], state)
             + jnp.einsum('bhij,bhjv->bhiv', intra, vnew))
        glast = gi[..., -1:]
        state = (state * jnp.exp(glast)[..., None]
                 + jnp.einsum('bhck,bhcv->bhkv', ki * jnp.exp(glast - gi)[..., None], vnew))
        return state, o

    s_fin, o = lax.scan(step, s0, (qc, kc, u, w, gcum, decay))
    o = jnp.moveaxis(jnp.moveaxis(o, 3, 2), 0, 1).reshape(b, n, h, dv)
    return o.astype(dt), s_fin.astype(dt)


def mixer_c(h, p, s0_f, s0_b):
    b, n, _ = h.shape
    pr = h @ p["in_w"]
    qkv = jax.nn.silu(depthwise_conv_centred(pr[..., :3 * MIX_W], p["conv_w"]))
    z = pr[..., 3 * MIX_W:4 * MIX_W]
    bgate = pr[..., 4 * MIX_W:4 * MIX_W + 2 * H_C].reshape(b, n, 2, H_C)
    agate = pr[..., 4 * MIX_W + 2 * H_C:].reshape(b, n, 2, H_C)
    q = l2norm(qkv[..., :MIX_W].reshape(b, n, H_C, DK_C)) * (DK_C ** -0.5)
    k = l2norm(qkv[..., MIX_W:2 * MIX_W].reshape(b, n, H_C, DK_C))
    v = qkv[..., 2 * MIX_W:].reshape(b, n, H_C, DV_C)
    beta = jax.nn.sigmoid(bgate.astype(F32))
    g = -jnp.exp(p["a_log"].astype(F32)) * jax.nn.softplus(agate.astype(F32) + p["dt_bias"].astype(F32))
    o_f, s_f = gated_delta_chunked(q, k, v, g[:, :, 0], beta[:, :, 0], s0_f)
    rev = lambda t: jnp.flip(t, axis=1)
    o_b, s_b = gated_delta_chunked(rev(q), rev(k), rev(v), rev(g[:, :, 1]), rev(beta[:, :, 1]), s0_b)
    o = rmsnorm(o_f + rev(o_b), p["onorm_w"])
    out = (o.reshape(b, n, MIX_W) * jax.nn.silu(z)) @ p["out_w"]
    return out, jnp.stack([s_f, s_b], axis=1)


def lambda_init_for(layer):
    return 0.8 - 0.6 * math.exp(-0.3 * layer)


def setup_inputs(seed: int = 0) -> dict:
    key = jax.random.key(seed)
    keys = iter(jax.random.split(key, 64))
    nrm = lambda shape, s: jax.random.normal(next(keys), shape, F32) * s
    gain = lambda m: 1.0 + nrm((m,), 0.02)
    d = D_MODEL
    inp = {}
    inp["x_prompt"] = nrm((BATCH, SEQ, d), 1.0)
    inp["x_sample"] = nrm((DEC_BATCH, DEC_SEQ, d), 1.0)
    inp["cache_l0_k"] = nrm((DEC_BATCH, PAST_LEN, HKV_A, DH_A), 1.0)
    inp["cache_l0_v"] = nrm((DEC_BATCH, PAST_LEN, HKV_A, DH_A), 1.0)
    inp["cache_l1_k"] = nrm((DEC_BATCH, PAST_LEN, H_B, 2, DH_B), 1.0)
    inp["cache_l1_v"] = nrm((DEC_BATCH, PAST_LEN, H_B, 2 * DH_B), 1.0)
    inp["state_l2"] = nrm((DEC_BATCH, 2, H_C, DK_C, DV_C), 0.3)
    inp["cache_l3_k"] = nrm((DEC_BATCH, PAST_LEN, HKV_A, DH_A), 1.0)
    inp["cache_l3_v"] = nrm((DEC_BATCH, PAST_LEN, HKV_A, DH_A), 1.0)
    inp["c"] = nrm((DEC_BATCH, d), 1.0)
    inp["c_ctx"] = nrm((d,), 1.0)

    def common(i, in_dim):
        inp[f"l{i}_norm_w"] = gain(d)
        inp[f"l{i}_mod_w"] = nrm((d, 3 * d), 0.5 * d ** -0.5)
        inp[f"l{i}_mod_b"] = nrm((3 * d,), 0.01)
        inp[f"l{i}_in_w"] = nrm((d, in_dim), d ** -0.5)
        inp[f"l{i}_out_w"] = nrm((MIX_W, d), MIX_W ** -0.5)

    common(0, IN_A)
    inp["l0_sink"] = nrm((HQ_A,), 0.5)
    common(1, IN_B)
    inp["l1_lambda_q1"] = nrm((DH_B,), 0.1)
    inp["l1_lambda_k1"] = nrm((DH_B,), 0.1)
    inp["l1_lambda_q2"] = nrm((DH_B,), 0.1)
    inp["l1_lambda_k2"] = nrm((DH_B,), 0.1)
    inp["l1_subln_w"] = gain(2 * DH_B)
    common(2, IN_C)
    inp["l2_conv_w"] = nrm((CONV_K, 3 * MIX_W), CONV_K ** -0.5)
    inp["l2_a_log"] = jnp.log(jax.random.uniform(next(keys), (2, H_C), F32, 1.0, 16.0))
    dtv = jnp.exp(jax.random.uniform(next(keys), (2, H_C), F32, math.log(1e-3), math.log(1e-1)))
    inp["l2_dt_bias"] = dtv + jnp.log(-jnp.expm1(-dtv))
    inp["l2_onorm_w"] = gain(DV_C)
    common(3, IN_A)
    inp["l3_sink"] = nrm((HQ_A,), 0.5)
    inp["final_norm_w"] = gain(d)
    return inp


def reference(x_prompt, x_sample, cache_l0_k, cache_l0_v, cache_l1_k, cache_l1_v, state_l2,
              cache_l3_k, cache_l3_v, c, c_ctx,
              l0_norm_w, l0_mod_w, l0_mod_b, l0_in_w, l0_out_w, l0_sink,
              l1_norm_w, l1_mod_w, l1_mod_b, l1_in_w, l1_out_w,
              l1_lambda_q1, l1_lambda_k1, l1_lambda_q2, l1_lambda_k2, l1_subln_w,
              l2_norm_w, l2_mod_w, l2_mod_b, l2_in_w, l2_out_w,
              l2_conv_w, l2_a_log, l2_dt_bias, l2_onorm_w,
              l3_norm_w, l3_mod_w, l3_mod_b, l3_in_w, l3_out_w, l3_sink,
              final_norm_w):
    layers = [
        dict(norm_w=l0_norm_w, mod_w=l0_mod_w, mod_b=l0_mod_b, in_w=l0_in_w, out_w=l0_out_w, sink=l0_sink),
        dict(norm_w=l1_norm_w, mod_w=l1_mod_w, mod_b=l1_mod_b, in_w=l1_in_w, out_w=l1_out_w,
             lq1=l1_lambda_q1, lk1=l1_lambda_k1, lq2=l1_lambda_q2, lk2=l1_lambda_k2, subln_w=l1_subln_w),
        dict(norm_w=l2_norm_w, mod_w=l2_mod_w, mod_b=l2_mod_b, in_w=l2_in_w, out_w=l2_out_w,
             conv_w=l2_conv_w, a_log=l2_a_log, dt_bias=l2_dt_bias, onorm_w=l2_onorm_w),
        dict(norm_w=l3_norm_w, mod_w=l3_mod_w, mod_b=l3_mod_b, in_w=l3_in_w, out_w=l3_out_w, sink=l3_sink),
    ]
    caches = [(cache_l0_k, cache_l0_v), (cache_l1_k, cache_l1_v), (state_l2,), (cache_l3_k, cache_l3_v)]

    xc, xl = x_prompt, x_sample
    new_state = []
    for i in range(DEPTH):
        p = layers[i]
        hc, gate_c = ada_modulate(xc, p["norm_w"], p["mod_w"], p["mod_b"], c_ctx[None, :])
        hl, gate_l = ada_modulate(xl, p["norm_w"], p["mod_w"], p["mod_b"], c)
        kind = i % N_MIXERS
        if kind == 0:
            oc, kc_new, vc_new = mixer_a_context(hc, p)
            ol = mixer_a_latent(hl, p, caches[i][0], caches[i][1])
            new_state += [kc_new, vc_new]
        elif kind == 1:
            lam_init = lambda_init_for(i)
            oc, kc_new, vc_new = mixer_b_context(hc, p, lam_init)
            ol = mixer_b_latent(hl, p, lam_init, caches[i][0], caches[i][1])
            new_state += [kc_new, vc_new]
        else:
            zeros = jnp.zeros((xc.shape[0], H_C, DK_C, DV_C), xc.dtype)
            oc, st_new = mixer_c(hc, p, zeros, zeros)
            ol, _ = mixer_c(hl, p, caches[i][0][:, 0], caches[i][0][:, 1])
            new_state.append(st_new)
        xc = xc + gate_c * oc
        xl = xl + gate_l * ol

    y_prompt = rmsnorm(xc, final_norm_w)
    y_sample = rmsnorm(xl, final_norm_w)
    new_l0_k, new_l0_v, new_l1_k, new_l1_v, new_l2_state, new_l3_k, new_l3_v = new_state
    return (y_prompt, y_sample, new_l0_k, new_l0_v, new_l1_k, new_l1_v, new_l2_state, new_l3_k, new_l3_v)
```

```cpp
#include <hip/hip_runtime.h>
#include <hip/hip_bf16.h>
#include <hip/hip_cooperative_groups.h>
#include <cstdio>
namespace cg = cooperative_groups;

#define ONE_LAUNCH 1
#define DUP_P0 0
#define DUP_GEMM 0
#define DUP_ATT 0
#define DUP_DN 0
#define DUP_DN2 0
#define DUP_SYNC 0
#define DUP_NORM 0
#define DUP_OUT 0

typedef unsigned short u16;
using bf16x8 = __attribute__((ext_vector_type(8))) short;
using f32x4 = __attribute__((ext_vector_type(4))) float;
#define DI __device__ __forceinline__

constexpr size_t OFF_X    = 0;
constexpr size_t OFF_H    = OFF_X + 33554432;
constexpr size_t OFF_PR   = OFF_H + 16777216;
constexpr size_t OFF_WTIN = OFF_PR + 69206016;
constexpr size_t WTIN_L0 = 0, WTIN_L1 = 5242880, WTIN_L2 = WTIN_L1 + 8388608, WTIN_L3 = WTIN_L2 + 8650752;
constexpr size_t OFF_WTOUT = OFF_WTIN + 27525120;
constexpr size_t OFF_QN   = OFF_WTOUT + 8388608;
constexpr size_t OFF_KN   = OFF_QN + 16777216;
constexpr size_t OFF_VV   = OFF_KN + 16777216;
constexpr size_t OFF_TM   = OFF_VV + 16777216;
constexpr size_t OFF_OFB  = OFF_TM + 16777216;
constexpr size_t OFF_MOD  = OFF_OFB + 33554432;
constexpr size_t OFF_GATES= OFF_MOD + 245760;
constexpr size_t OFF_GB   = OFF_GATES + 1048576;
constexpr size_t OFF_ROPE = OFF_GB + 1048576;
constexpr size_t OFF_LAM  = OFF_ROPE + 8192;
constexpr size_t OFF_BAR  = OFF_LAM + 256;
constexpr size_t OFF_CK0  = OFF_BAR + 16384;
constexpr size_t OFF_CV0  = OFF_CK0 + 1048576;
constexpr size_t OFF_CK3  = OFF_CV0 + 1048576;
constexpr size_t OFF_CV3  = OFF_CK3 + 1048576;
constexpr size_t OFF_SS   = OFF_CV3 + 1048576;
constexpr size_t OFF_SW   = OFF_SS + 131072;
constexpr size_t WS_END   = OFF_SW + 337920;
constexpr size_t OFF_HR   = OFF_OFB + 8388608;
constexpr size_t OFF_CK1  = OFF_OFB;
constexpr size_t OFF_CV1  = OFF_OFB + 4194304;
constexpr size_t OFF_VT   = OFF_VV;

constexpr size_t OUT_Y = 0, OUT_L0K = 8388608, OUT_L0V = 9437184, OUT_L1K = 10485760, OUT_L1V = 14680064,
                 OUT_L2S = 18874368, OUT_L3K = 23068672, OUT_L3V = 24117248;

constexpr int SMEM_BYTES = 77824;
constexpr float NORM_EPS = 1e-6f;

struct Params {
  const float* in[43];
  float* out;
  char* ws;
};

__host__ __device__ constexpr int lbase(int l) { return l == 0 ? 11 : (l == 1 ? 17 : (l == 2 ? 27 : 36)); }

typedef __bf16 bf16x2_t __attribute__((ext_vector_type(2)));
typedef float f32x2_t __attribute__((ext_vector_type(2)));
DI u16 f2bf(float x) { __bf16 b = (__bf16)x; return __builtin_bit_cast(u16, b); }
DI float bf2f(u16 h) { return __uint_as_float(((unsigned)h) << 16); }
DI unsigned pack2(float a, float b) { f32x2_t v = {a, b}; bf16x2_t r = __builtin_convertvector(v, bf16x2_t); return __builtin_bit_cast(unsigned, r); }
DI float silu(float x) { return x / (1.f + __expf(-x)); }
DI float wave_sum(float v) { for (int o = 32; o; o >>= 1) v += __shfl_xor(v, o); return v; }
DI float grp16_sum(float v) { v += __shfl_xor(v, 1); v += __shfl_xor(v, 2); v += __shfl_xor(v, 4); v += __shfl_xor(v, 8); return v; }
DI float grp16_max(float v) { v = fmaxf(v, __shfl_xor(v, 1)); v = fmaxf(v, __shfl_xor(v, 2)); v = fmaxf(v, __shfl_xor(v, 4)); v = fmaxf(v, __shfl_xor(v, 8)); return v; }
DI f32x4 mfma(bf16x8 a, bf16x8 b, f32x4 c) { return __builtin_amdgcn_mfma_f32_16x16x32_bf16(a, b, c, 0, 0, 0); }
DI bf16x8 ldf(const u16* p) { return *reinterpret_cast<const bf16x8*>(p); }
DI f32x4 zero4() { f32x4 z = {0.f, 0.f, 0.f, 0.f}; return z; }

DI void phase0(const Params& p, char* smem) {
  const int tid = threadIdx.x;
  constexpr int NT_MOD = 384, NT_TR = 1680 + 512 + 384, NT_CK = 768;
  for (int task = blockIdx.x; task < NT_MOD + NT_TR + NT_CK + 1; task += gridDim.x) {
    __syncthreads();
    if (task < NT_MOD) {
      const int l = task / 96, cgp = task % 96;
      float* sc = (float*)smem;
      float* red = sc + 5 * 1024;
      for (int i = tid; i < 5 * 1024; i += 256) {
        int c = i >> 10, k = i & 1023;
        float v = (c == 0) ? p.in[10][k] : p.in[9][(c - 1) * 1024 + k];
        sc[i] = v / (1.f + expf(-v));
      }
      __syncthreads();
      const float* W = p.in[lbase(l) + 1];
      const float* mb = p.in[lbase(l) + 2];
      const int kg = tid >> 3, cp = tid & 7, n = cgp * 32 + cp * 4;
      float4 a[5];
#pragma unroll
      for (int c = 0; c < 5; ++c) a[c] = make_float4(0.f, 0.f, 0.f, 0.f);
      const float* wp = W + (size_t)(kg * 32) * 3072 + n;
#pragma unroll 16
      for (int k = 0; k < 32; ++k) {
        const float4 wv = *reinterpret_cast<const float4*>(wp + (size_t)k * 3072);
#pragma unroll
        for (int c = 0; c < 5; ++c) { const float s = sc[c * 1024 + kg * 32 + k]; a[c].x += s * wv.x; a[c].y += s * wv.y; a[c].z += s * wv.z; a[c].w += s * wv.w; }
      }
#pragma unroll
      for (int c = 0; c < 5; ++c) *reinterpret_cast<float4*>(red + (kg * 5 + c) * 32 + cp * 4) = a[c];
      __syncthreads();
      float* MOD = (float*)(p.ws + OFF_MOD);
      if (tid < 160) {
        const int c = tid >> 5, col = tid & 31;
        float s = 0.f;
#pragma unroll
        for (int g = 0; g < 32; ++g) s += red[(g * 5 + c) * 32 + col];
        s += mb[cgp * 32 + col];
        MOD[(l * 5 + c) * 3072 + cgp * 32 + col] = s;
      }
    } else if (task < NT_MOD + NT_TR) {
      int tt = task - NT_MOD;
      const float* W; u16* WT; int N, sld, dld, kt, nt; bool vperm = false;
      if (tt < 1680) {
        int l, local, nn;
        if (tt < 320) { l = 0; local = tt; nn = 20; N = 2560; WT = (u16*)(p.ws + OFF_WTIN + WTIN_L0); }
        else if (tt < 832) { l = 1; local = tt - 320; nn = 32; N = 4096; WT = (u16*)(p.ws + OFF_WTIN + WTIN_L1); }
        else if (tt < 1360) { l = 2; local = tt - 832; nn = 33; N = 4128; WT = (u16*)(p.ws + OFF_WTIN + WTIN_L2); }
        else { l = 3; local = tt - 1360; nn = 20; N = 2560; WT = (u16*)(p.ws + OFF_WTIN + WTIN_L3); }
        W = p.in[lbase(l) + 3]; sld = N; dld = 1024;
        nt = (local % nn) * 2; kt = local / nn;
      } else if (tt < 2192) {
        int t2 = tt - 1680; int l = t2 >> 7; int local = t2 & 127;
        W = p.in[lbase(l) + 4]; WT = (u16*)(p.ws + OFF_WTOUT + (size_t)l * 2097152); N = 1024; sld = 1024; dld = 1024;
        nt = (local & 7) * 2; kt = local >> 3;
      } else {
        int t3 = tt - 2192, F, local; size_t doff;
        if (t3 < 64) { W = p.in[3]; F = 256; local = t3; doff = OFF_CV0; }
        else if (t3 < 128) { W = p.in[8]; F = 256; local = t3 - 64; doff = OFF_CV3; }
        else { W = p.in[5]; F = 1024; local = t3 - 128; doff = OFF_CV1; }
        const int per_b = 8 * (F / 128);
        const int b = local / per_b, r = local % per_b;
        kt = r & 7; nt = (r >> 3) * 2;
        W += (size_t)b * 512 * F; WT = (u16*)(p.ws + doff) + (size_t)b * F * 512; N = F; sld = F; dld = 512; vperm = true;
      }
      float* tl = (float*)smem;
      {
        const int kk0 = tid >> 4, nn = (tid & 15) * 4;
        float4 v4[2][4];
#pragma unroll
        for (int hh = 0; hh < 2; ++hh) {
          const int n = (nt + hh) * 64 + nn;
#pragma unroll
          for (int i = 0; i < 4; ++i)
            v4[hh][i] = (n < N) ? *reinterpret_cast<const float4*>(W + (size_t)(kt * 64 + kk0 + 16 * i) * sld + n) : make_float4(0.f, 0.f, 0.f, 0.f);
        }
#pragma unroll
        for (int hh = 0; hh < 2; ++hh)
#pragma unroll
          for (int i = 0; i < 4; ++i) {
            float* d = tl + hh * 4160 + (kk0 + 16 * i) * 65 + nn;
            d[0] = v4[hh][i].x; d[1] = v4[hh][i].y; d[2] = v4[hh][i].z; d[3] = v4[hh][i].w;
          }
      }
      __syncthreads();
#pragma unroll
      for (int hh = 0; hh < 2; ++hh)
#pragma unroll
        for (int i = 0; i < 2; ++i) {
          const int nn = i * 32 + (tid >> 3), kc = tid & 7;
          const float* s = tl + hh * 4160 + (kc * 8) * 65 + nn;
          uint4 o;
          o.x = pack2(s[0], s[65]); o.y = pack2(s[130], s[195]); o.z = pack2(s[260], s[325]); o.w = pack2(s[390], s[455]);
          u16* dp = WT + (size_t)((nt + hh) * 64 + nn) * dld + kt * 64;
          if (vperm) {
            const int pb = (kc >> 2) * 32 + ((kc & 3) >> 1) * 4 + (kc & 1) * 16;
            uint2 lo2; lo2.x = o.x; lo2.y = o.y; uint2 hi2; hi2.x = o.z; hi2.y = o.w;
            *reinterpret_cast<uint2*>(dp + pb) = lo2;
            *reinterpret_cast<uint2*>(dp + pb + 8) = hi2;
          } else {
            *reinterpret_cast<uint4*>(dp + kc * 8) = o;
          }
        }
    } else if (task < NT_MOD + NT_TR + NT_CK) {
      int t4 = task - NT_MOD - NT_TR;
      const float* s; u16* d;
      if (t4 < 128) { s = p.in[2]; d = (u16*)(p.ws + OFF_CK0); }
      else if (t4 < 256) { s = p.in[7]; d = (u16*)(p.ws + OFF_CK3); t4 -= 128; }
      else { s = p.in[4]; d = (u16*)(p.ws + OFF_CK1); t4 -= 256; }
      const size_t base = (size_t)t4 * 4096 + tid * 16;
#pragma unroll
      for (int i = 0; i < 2; ++i) {
        const float4 a = *reinterpret_cast<const float4*>(s + base + i * 8), b4 = *reinterpret_cast<const float4*>(s + base + i * 8 + 4);
        uint4 o; o.x = pack2(a.x, a.y); o.y = pack2(a.z, a.w); o.z = pack2(b4.x, b4.y); o.w = pack2(b4.z, b4.w);
        *reinterpret_cast<uint4*>(d + base + i * 8) = o;
      }
    } else {
      float2* rope = (float2*)(p.ws + OFF_ROPE);
      for (int i = tid; i < 1024; i += 256) {
        int pos = i >> 4, f = i & 15;
        float inv = powf(10000.0f, -(float)f / 16.0f);
        float ang = (float)pos * inv;
        rope[i] = make_float2(cosf(ang), sinf(ang));
      }
      if (tid == 0) {
        float d1 = 0.f, d2 = 0.f;
        for (int i = 0; i < 64; ++i) { d1 += p.in[22][i] * p.in[23][i]; d2 += p.in[24][i] * p.in[25][i]; }
        float lam_init = 0.8f - 0.6f * expf(-0.3f);
        float* LAM = (float*)(p.ws + OFF_LAM);
        LAM[0] = expf(d1) - expf(d2) + lam_init;
        LAM[1] = lam_init;
        LAM[2] = 0.f;
      }
      {
        float4* ssz = (float4*)(p.ws + OFF_SS);
        for (int i = tid; i < 8192; i += 256) ssz[i] = make_float4(0.f, 0.f, 0.f, 0.f);
      }
    }
  }
}

DI void sw_tasks(const Params& p) {
  const int lane = threadIdx.x & 63, w = threadIdx.x >> 6;
  const float* MOD = (const float*)(p.ws + OFF_MOD);
  float* SW = (float*)(p.ws + OFF_SW);
  for (int task = blockIdx.x * 4 + w; task < 1348; task += gridDim.x * 4) {
    int l, t8; const u16* WT;
    if (task < 512) { l = 1; t8 = task; WT = (const u16*)(p.ws + OFF_WTIN + WTIN_L1); }
    else if (task < 1028) { l = 2; t8 = task - 512; WT = (const u16*)(p.ws + OFF_WTIN + WTIN_L2); }
    else { l = 3; t8 = task - 1028; WT = (const u16*)(p.ws + OFF_WTIN + WTIN_L3); }
    float sh[5][16];
#pragma unroll
    for (int c = 0; c < 5; ++c)
#pragma unroll
      for (int q4 = 0; q4 < 4; ++q4) {
        const float4 v = *reinterpret_cast<const float4*>(MOD + (size_t)(l * 5 + c) * 3072 + lane * 16 + q4 * 4);
        sh[c][q4 * 4] = v.x; sh[c][q4 * 4 + 1] = v.y; sh[c][q4 * 4 + 2] = v.z; sh[c][q4 * 4 + 3] = v.w;
      }
#pragma unroll 2
    for (int r = 0; r < 8; ++r) {
      const int n = t8 * 8 + r;
      const uint4 w0 = *reinterpret_cast<const uint4*>(WT + (size_t)n * 1024 + lane * 16);
      const uint4 w1 = *reinterpret_cast<const uint4*>(WT + (size_t)n * 1024 + lane * 16 + 8);
      float wf[16];
      wf[0] = bf2f((u16)(w0.x & 0xffff)); wf[1] = bf2f((u16)(w0.x >> 16)); wf[2] = bf2f((u16)(w0.y & 0xffff)); wf[3] = bf2f((u16)(w0.y >> 16));
      wf[4] = bf2f((u16)(w0.z & 0xffff)); wf[5] = bf2f((u16)(w0.z >> 16)); wf[6] = bf2f((u16)(w0.w & 0xffff)); wf[7] = bf2f((u16)(w0.w >> 16));
      wf[8] = bf2f((u16)(w1.x & 0xffff)); wf[9] = bf2f((u16)(w1.x >> 16)); wf[10] = bf2f((u16)(w1.y & 0xffff)); wf[11] = bf2f((u16)(w1.y >> 16));
      wf[12] = bf2f((u16)(w1.z & 0xffff)); wf[13] = bf2f((u16)(w1.z >> 16)); wf[14] = bf2f((u16)(w1.w & 0xffff)); wf[15] = bf2f((u16)(w1.w >> 16));
#pragma unroll
      for (int c = 0; c < 5; ++c) {
        float s = 0.f;
#pragma unroll
        for (int k = 0; k < 16; ++k) s += sh[c][k] * wf[k];
        s = wave_sum(s);
        if (lane == 0) SW[(size_t)(l * 5 + c) * 4224 + n] = s;
      }
    }
  }
}

DI void norm_phase(const Params& p, int layer) {
  int tid_l = threadIdx.x;
  asm volatile("" : "+v"(tid_l));
  const int lane = tid_l & 63, w = tid_l >> 6;
  float* X = (float*)(p.ws + OFF_X);
  u16* H = (u16*)(p.ws + OFF_H);
  const float* MOD = (const float*)(p.ws + OFF_MOD);
  const float* nw = (layer < 4) ? p.in[lbase(layer)] : p.in[42];
  const int rstride = gridDim.x * 4;
  float4 vn[4];
  {
    const int r0 = blockIdx.x * 4 + w;
    const float* s0 = (layer == 0) ? (r0 < 4096 ? p.in[0] + (size_t)r0 * 1024 : p.in[1] + (size_t)(r0 - 4096) * 1024) : X + (size_t)r0 * 1024;
#pragma unroll
    for (int i = 0; i < 4; ++i) vn[i] = (r0 < 8192) ? *reinterpret_cast<const float4*>(s0 + (i * 64 + lane) * 4) : make_float4(0.f, 0.f, 0.f, 0.f);
  }
  for (int r = blockIdx.x * 4 + w; r < 8192; r += rstride) {
    float4 v[4];
    float ss = 0.f;
#pragma unroll
    for (int i = 0; i < 4; ++i) v[i] = vn[i];
    {
      const int r1 = r + rstride;
      if (r1 < 8192) {
        const float* s1 = (layer == 0) ? (r1 < 4096 ? p.in[0] + (size_t)r1 * 1024 : p.in[1] + (size_t)(r1 - 4096) * 1024) : X + (size_t)r1 * 1024;
#pragma unroll
        for (int i = 0; i < 4; ++i) vn[i] = *reinterpret_cast<const float4*>(s1 + (i * 64 + lane) * 4);
      }
    }
#pragma unroll
    for (int i = 0; i < 4; ++i) ss += v[i].x * v[i].x + v[i].y * v[i].y + v[i].z * v[i].z + v[i].w * v[i].w;
    ss = wave_sum(ss);
    const float rs = rsqrtf(ss * (1.f / 1024.f) + NORM_EPS);
    if (layer < 4) {
      const int cond = r < 4096 ? 0 : 1 + ((r - 4096) >> 10);
      const float* md = MOD + (size_t)(layer * 5 + cond) * 3072;
#pragma unroll
      for (int i = 0; i < 4; ++i) {
        const int n = (i * 64 + lane) * 4;
        float4 g = *reinterpret_cast<const float4*>(nw + n);
        float4 sh = *reinterpret_cast<const float4*>(md + n);
        float4 sc = *reinterpret_cast<const float4*>(md + 1024 + n);
        float h0 = v[i].x * rs * g.x * (1.f + sc.x) + sh.x;
        float h1 = v[i].y * rs * g.y * (1.f + sc.y) + sh.y;
        float h2 = v[i].z * rs * g.z * (1.f + sc.z) + sh.z;
        float h3 = v[i].w * rs * g.w * (1.f + sc.w) + sh.w;
        uint2 pk; pk.x = pack2(h0, h1); pk.y = pack2(h2, h3);
        *reinterpret_cast<uint2*>(H + (size_t)r * 1024 + n) = pk;
      }
    } else {
#pragma unroll
      for (int i = 0; i < 4; ++i) {
        const int n = (i * 64 + lane) * 4;
        float4 g = *reinterpret_cast<const float4*>(nw + n);
        float4 o; o.x = v[i].x * rs * g.x; o.y = v[i].y * rs * g.y; o.z = v[i].z * rs * g.z; o.w = v[i].w * rs * g.w;
        *reinterpret_cast<float4*>(p.out + OUT_Y + (size_t)r * 1024 + n) = o;
      }
    }
  }
}

struct EpiArgs {
  int kind;
  int ld;
  int rope_end;
  int k_beg, k_end, v_end, kw;
  float* outk; float* outv;
  int layer;
  int fused;
};

DI void gemm_phase(const Params& p, char* smem, const u16* __restrict__ A, const u16* __restrict__ WT, int ntn, const EpiArgs e) {
  u16* As = (u16*)smem;
  u16* Bs = As + 2 * 128 * 64;
  const int tid = threadIdx.x, lane = tid & 63, w = tid >> 6, wm = w >> 1, wn = w & 1, l16 = lane & 15, quad = lane >> 4;
  const int ntiles = 64 * ntn;
  u16* PR = (u16*)(p.ws + OFF_PR);
  const int xg = blockIdx.x & 7, xl = blockIdx.x >> 3, xn = gridDim.x >> 3;
  (void)ntiles;
  for (int t = xl; t < 8 * ntn; t += xn) {
    const int tm = xg * 8 + (t & 7), tn = t >> 3;
    const int m0 = tm * 128, n0 = tn * 128;
    f32x4 acc[4][4];
#pragma unroll
    for (int i = 0; i < 4; ++i)
#pragma unroll
      for (int j = 0; j < 4; ++j) acc[i][j] = zero4();
    const u16* Ag = A + (size_t)m0 * 1024;
    const u16* Bg = WT + (size_t)n0 * 1024;
    const int lrow = tid >> 3, lkc = tid & 7;
    const char* Abase = (const char*)A;
    const char* Bbase = (const char*)WT;
    const unsigned aoff = (unsigned)((m0 + lrow) * 1024 + lkc * 8) * 2u;
    const unsigned boff = (unsigned)((n0 + lrow) * 1024 + lkc * 8) * 2u;
    u16* Ast = As + lrow * 64 + ((lkc ^ (lrow & 7)) * 8);
    u16* Bst = Bs + lrow * 64 + ((lkc ^ (lrow & 7)) * 8);
#define G_LD1(base_, off_) (*reinterpret_cast<const uint4*>((base_) + (off_)))
#define G_LOAD(S, kt_) \
    S##a0 = G_LD1(Abase, aoff + (unsigned)(kt_) * 128u); S##a1 = G_LD1(Abase, aoff + 65536u + (unsigned)(kt_) * 128u); \
    S##a2 = G_LD1(Abase, aoff + 131072u + (unsigned)(kt_) * 128u); S##a3 = G_LD1(Abase, aoff + 196608u + (unsigned)(kt_) * 128u); \
    S##b0 = G_LD1(Bbase, boff + (unsigned)(kt_) * 128u); S##b1 = G_LD1(Bbase, boff + 65536u + (unsigned)(kt_) * 128u); \
    S##b2 = G_LD1(Bbase, boff + 131072u + (unsigned)(kt_) * 128u); S##b3 = G_LD1(Bbase, boff + 196608u + (unsigned)(kt_) * 128u);
#define G_STORE(S, buf_) \
    *reinterpret_cast<uint4*>(Ast + (buf_) * 8192) = S##a0; *reinterpret_cast<uint4*>(Ast + (buf_) * 8192 + 32 * 64) = S##a1; \
    *reinterpret_cast<uint4*>(Ast + (buf_) * 8192 + 64 * 64) = S##a2; *reinterpret_cast<uint4*>(Ast + (buf_) * 8192 + 96 * 64) = S##a3; \
    *reinterpret_cast<uint4*>(Bst + (buf_) * 8192) = S##b0; *reinterpret_cast<uint4*>(Bst + (buf_) * 8192 + 32 * 64) = S##b1; \
    *reinterpret_cast<uint4*>(Bst + (buf_) * 8192 + 64 * 64) = S##b2; *reinterpret_cast<uint4*>(Bst + (buf_) * 8192 + 96 * 64) = S##b3;
#define G_COMPUTE(buf_) { \
      const u16* Ab = As + (buf_) * 8192 + (wm * 64 + l16) * 64; \
      const u16* Bb = Bs + (buf_) * 8192 + (wn * 64 + l16) * 64; \
      _Pragma("unroll") for (int ks = 0; ks < 2; ++ks) { \
        const int co = ((ks * 4 + quad) ^ (l16 & 7)) * 8; \
        bf16x8 af0 = ldf(Ab + co), af1 = ldf(Ab + 16 * 64 + co), af2 = ldf(Ab + 32 * 64 + co), af3 = ldf(Ab + 48 * 64 + co); \
        bf16x8 bf0 = ldf(Bb + co), bf1 = ldf(Bb + 16 * 64 + co), bf2 = ldf(Bb + 32 * 64 + co), bf3 = ldf(Bb + 48 * 64 + co); \
        acc[0][0] = mfma(bf0, af0, acc[0][0]); acc[0][1] = mfma(bf1, af0, acc[0][1]); acc[0][2] = mfma(bf2, af0, acc[0][2]); acc[0][3] = mfma(bf3, af0, acc[0][3]); \
        acc[1][0] = mfma(bf0, af1, acc[1][0]); acc[1][1] = mfma(bf1, af1, acc[1][1]); acc[1][2] = mfma(bf2, af1, acc[1][2]); acc[1][3] = mfma(bf3, af1, acc[1][3]); \
        acc[2][0] = mfma(bf0, af2, acc[2][0]); acc[2][1] = mfma(bf1, af2, acc[2][1]); acc[2][2] = mfma(bf2, af2, acc[2][2]); acc[2][3] = mfma(bf3, af2, acc[2][3]); \
        acc[3][0] = mfma(bf0, af3, acc[3][0]); acc[3][1] = mfma(bf1, af3, acc[3][1]); acc[3][2] = mfma(bf2, af3, acc[3][2]); acc[3][3] = mfma(bf3, af3, acc[3][3]); \
      } }
    uint4 Ra0, Ra1, Ra2, Ra3, Rb0, Rb1, Rb2, Rb3, Qa0, Qa1, Qa2, Qa3, Qb0, Qb1, Qb2, Qb3;
    G_LOAD(R, 0)
    G_LOAD(Q, 1)
    __syncthreads();
    G_STORE(R, 0)
    __syncthreads();
    for (int kt = 0; kt < 16; kt += 2) {
      const int k2 = kt + 2 < 16 ? kt + 2 : 14, k3 = kt + 3 < 16 ? kt + 3 : 15;
#define G_SCHED \
      __builtin_amdgcn_sched_group_barrier(0x100, 6, 0); \
      _Pragma("unroll") for (int sg_ = 0; sg_ < 2; ++sg_) { __builtin_amdgcn_sched_group_barrier(0x008, 1, 0); __builtin_amdgcn_sched_group_barrier(0x100, 1, 0); } \
      _Pragma("unroll") for (int sg_ = 0; sg_ < 8; ++sg_) { __builtin_amdgcn_sched_group_barrier(0x008, 2, 0); __builtin_amdgcn_sched_group_barrier(0x020, 1, 0); __builtin_amdgcn_sched_group_barrier(0x100, 1, 0); } \
      _Pragma("unroll") for (int sg_ = 0; sg_ < 7; ++sg_) { __builtin_amdgcn_sched_group_barrier(0x008, 2, 0); __builtin_amdgcn_sched_group_barrier(0x200, 1, 0); } \
      __builtin_amdgcn_sched_group_barrier(0x200, 1, 0);
      __builtin_amdgcn_sched_barrier(0);
      __builtin_amdgcn_s_setprio(1);
      G_LOAD(R, k2)
      G_COMPUTE(0)
      G_STORE(Q, 1)
      G_SCHED
      __builtin_amdgcn_sched_barrier(0);
      __builtin_amdgcn_s_setprio(0);
      __syncthreads();
      __builtin_amdgcn_s_setprio(1);
      G_LOAD(Q, k3)
      G_COMPUTE(1)
      G_STORE(R, 0)
      G_SCHED
      __builtin_amdgcn_sched_barrier(0);
      __builtin_amdgcn_s_setprio(0);
      __syncthreads();
#undef G_SCHED
    }
#undef G_LOAD
#undef G_LD1
#undef G_STORE
#undef G_COMPUTE
    const int nw = n0 + wn * 64;
    const int rbase = m0 + wm * 64 + l16;
    const int cq = quad * 4;
    if (e.kind <= 1 && e.fused) {
      const int cond = m0 < 4096 ? 0 : 1 + ((m0 - 4096) >> 10);
      const float* SS = (const float*)(p.ws + OFF_SS) + (size_t)e.layer * 8192;
      const float* SW = (const float*)(p.ws + OFF_SW) + (size_t)(e.layer * 5 + cond) * 4224 + nw + cq;
      float4 sw[4];
#pragma unroll
      for (int nb = 0; nb < 4; ++nb) sw[nb] = *reinterpret_cast<const float4*>(SW + nb * 16);
#pragma unroll
      for (int mb = 0; mb < 4; ++mb) {
        const float rs = rsqrtf(SS[rbase + mb * 16] * (1.f / 1024.f) + NORM_EPS);
#pragma unroll
        for (int nb = 0; nb < 4; ++nb) {
          acc[mb][nb][0] = rs * acc[mb][nb][0] + sw[nb].x; acc[mb][nb][1] = rs * acc[mb][nb][1] + sw[nb].y;
          acc[mb][nb][2] = rs * acc[mb][nb][2] + sw[nb].z; acc[mb][nb][3] = rs * acc[mb][nb][3] + sw[nb].w;
        }
      }
    }
    if (e.kind == 0) {
      const bool lat = m0 >= 4096;
      const bool do_rope = lat && nw < e.rope_end;
      const bool is_v = nw >= e.k_end && nw < e.v_end;
      const float2* rope = (const float2*)(p.ws + OFF_ROPE);
      if (!is_v) {
#pragma unroll
        for (int mb = 0; mb < 4; ++mb) {
          const int row = rbase + mb * 16;
          if (do_rope) {
            const int t = (row - 4096) & 1023;
            const float2* rr = rope + (t >> 6) * 16 + cq;
            const float2* rc = rope + (t & 63) * 16 + cq;
#pragma unroll
            for (int r = 0; r < 4; ++r) {
              const float2 cr = rr[r], cc = rc[r];
              const float v0 = acc[mb][0][r], v1 = acc[mb][1][r], v2 = acc[mb][2][r], v3 = acc[mb][3][r];
              acc[mb][0][r] = v0 * cr.x - v1 * cr.y; acc[mb][1][r] = v1 * cr.x + v0 * cr.y;
              acc[mb][2][r] = v2 * cc.x - v3 * cc.y; acc[mb][3][r] = v3 * cc.x + v2 * cc.y;
            }
          }
          u16* dst = PR + (size_t)row * e.ld + nw + cq;
#pragma unroll
          for (int nb = 0; nb < 4; ++nb) {
            uint2 pk; pk.x = pack2(acc[mb][nb][0], acc[mb][nb][1]); pk.y = pack2(acc[mb][nb][2], acc[mb][nb][3]);
            *reinterpret_cast<uint2*>(dst + nb * 16) = pk;
          }
        }
      } else {
        u16* Vst = (u16*)smem + w * (64 * 72);
#pragma unroll
        for (int mb = 0; mb < 4; ++mb)
#pragma unroll
          for (int nb = 0; nb < 4; ++nb)
#pragma unroll
            for (int r = 0; r < 4; ++r)
              Vst[(nb * 16 + cq + r) * 72 + (mb >> 1) * 32 + ((l16 >> 2) & 3) * 8 + (mb & 1) * 4 + (l16 & 3)] = f2bf(acc[mb][nb][r]);
        __builtin_amdgcn_fence(__ATOMIC_RELEASE, "wavefront");
        __builtin_amdgcn_s_waitcnt(0xc07f);
        __builtin_amdgcn_wave_barrier();
        u16* VT = (u16*)(p.ws + OFF_VT);
#pragma unroll
        for (int i = 0; i < 8; ++i) {
          const int c = lane + 64 * i, col = c >> 3, rc = c & 7;
          const uint4 v = *reinterpret_cast<const uint4*>(Vst + col * 72 + rc * 8);
          *reinterpret_cast<uint4*>(VT + (size_t)(nw - e.k_end + col) * 8192 + m0 + wm * 64 + rc * 8) = v;
        }
      }
      if (!lat && nw >= e.k_beg && nw < e.v_end) {
        float* ob = (nw < e.k_end) ? e.outk + (nw - e.k_beg) : e.outv + (nw - e.k_end);
#pragma unroll
        for (int mb = 0; mb < 4; ++mb) {
          float* o = ob + (size_t)(rbase + mb * 16) * e.kw + cq;
#pragma unroll
          for (int nb = 0; nb < 4; ++nb) {
            float4 v; v.x = acc[mb][nb][0]; v.y = acc[mb][nb][1]; v.z = acc[mb][nb][2]; v.w = acc[mb][nb][3];
            *reinterpret_cast<float4*>(o + nb * 16) = v;
          }
        }
      }
    } else if (e.kind == 1) {
      float* GATES = (float*)(p.ws + OFF_GATES);
#pragma unroll
      for (int mb = 0; mb < 4; ++mb) {
        const int row = rbase + mb * 16;
#pragma unroll
        for (int nb = 0; nb < 4; ++nb) {
          const int col = nw + nb * 16 + cq;
          if (col < 4096) {
            uint2 pk; pk.x = pack2(acc[mb][nb][0], acc[mb][nb][1]); pk.y = pack2(acc[mb][nb][2], acc[mb][nb][3]);
            *reinterpret_cast<uint2*>(PR + (size_t)row * 4224 + col) = pk;
          } else if (col < 4128) {
            float4 v; v.x = acc[mb][nb][0]; v.y = acc[mb][nb][1]; v.z = acc[mb][nb][2]; v.w = acc[mb][nb][3];
            *reinterpret_cast<float4*>(GATES + (size_t)row * 32 + (col - 4096)) = v;
          }
        }
      }
    } else {
      float* X = (float*)(p.ws + OFF_X);
      const float* MOD = (const float*)(p.ws + OFF_MOD);
      const int cond = m0 < 4096 ? 0 : 1 + ((m0 - 4096) >> 10);
      const float* gate = MOD + (size_t)(e.layer * 5 + cond) * 3072 + 2048;
      const float gsc = (e.kind == 3) ? ((const float*)(p.ws + OFF_LAM))[2] : 1.f;
      const float* nwn = p.in[lbase(e.layer < 3 ? e.layer + 1 : 3)];
      const float* scn = MOD + (size_t)((e.layer < 3 ? e.layer + 1 : 3) * 5 + cond) * 3072 + 1024;
      u16* HR = (u16*)(p.ws + OFF_HR);
      float ssp[4] = {0.f, 0.f, 0.f, 0.f};
#pragma unroll
      for (int nb = 0; nb < 4; ++nb) {
        const int col = nw + nb * 16 + cq;
        float4 g = *reinterpret_cast<const float4*>(gate + col);
        g.x *= gsc; g.y *= gsc; g.z *= gsc; g.w *= gsc;
        float4 gm = make_float4(0.f, 0.f, 0.f, 0.f);
        if (e.fused) {
          const float4 a = *reinterpret_cast<const float4*>(nwn + col), b = *reinterpret_cast<const float4*>(scn + col);
          gm.x = a.x * (1.f + b.x); gm.y = a.y * (1.f + b.y); gm.z = a.z * (1.f + b.z); gm.w = a.w * (1.f + b.w);
        }
#pragma unroll
        for (int mb = 0; mb < 4; ++mb) {
          const int xrow = rbase + mb * 16;
          float* xp = X + (size_t)xrow * 1024 + col;
          const float* xs = (e.layer == 0) ? (xrow < 4096 ? p.in[0] + (size_t)xrow * 1024 + col : p.in[1] + (size_t)(xrow - 4096) * 1024 + col) : xp;
          float4 x = *reinterpret_cast<const float4*>(xs);
          x.x += g.x * acc[mb][nb][0]; x.y += g.y * acc[mb][nb][1]; x.z += g.z * acc[mb][nb][2]; x.w += g.w * acc[mb][nb][3];
          *reinterpret_cast<float4*>(xp) = x;
          if (e.fused) {
            ssp[mb] += x.x * x.x + x.y * x.y + x.z * x.z + x.w * x.w;
            uint2 pk; pk.x = pack2(x.x * gm.x, x.y * gm.y); pk.y = pack2(x.z * gm.z, x.w * gm.w);
            *reinterpret_cast<uint2*>(HR + (size_t)(rbase + mb * 16) * 1024 + col) = pk;
          }
        }
      }
      if (e.fused) {
        float* SSn = (float*)(p.ws + OFF_SS) + (size_t)(e.layer + 1) * 8192;
#pragma unroll
        for (int mb = 0; mb < 4; ++mb) {
          float s = ssp[mb];
          s += __shfl_xor(s, 16); s += __shfl_xor(s, 32);
          if (quad == 0) atomicAdd(SSn + rbase + mb * 16, s);
        }
      }
    }
  }
}

struct AttnItem {
  const u16* kb; int ldk;
  const u16* vtb;
  const u16* kc; int ldkc;
  const u16* vtc;
  int t_lo, n_loc, n_cache, mask;
};

template <int KW, int NDV>
DI void attn_core(char* smem, const AttnItem& it, const bf16x8 (&qf)[2][2], int koff, int qi0,
                  f32x4 (&O)[NDV][2], float (&mrun)[2], float (&lrun)[2]) {
  constexpr int KLD = KW + 16;
  constexpr int NKC = KW / 32;
  constexpr int NVC = NDV / 2;
  u16* Ks = (u16*)smem;
  u16* Vt = Ks + 64 * KLD;
  const int tid = threadIdx.x, lane = tid & 63, l16 = lane & 15, quad = lane >> 4;
  const int ntile = it.n_loc + it.n_cache;
  const int krow = tid / (KW / 8), kdc = tid % (KW / 8);
  const int vrow = tid >> 3, vdc = tid & 7;
  constexpr int KRS = 2048 / KW;
  uint4 pk0, pk1, pk2, pk3, pv0, pv1, pv2, pv3;
  uint4 qk0, qk1, qk2, qk3, qv0, qv1, qv2, qv3;
  pk2 = pk3 = pv2 = pv3 = make_uint4(0u, 0u, 0u, 0u);
  qk0 = qk1 = qk2 = qk3 = qv0 = qv1 = qv2 = qv3 = make_uint4(0u, 0u, 0u, 0u);
  constexpr bool DIST2 = (NKC == 2);
  int ld_ = it.ldk, vld_ = 8192;
  const u16* kp_ = it.kb + (size_t)(it.t_lo * 64 + krow) * it.ldk + kdc * 8;
  const u16* vp_ = it.vtb + (size_t)vrow * 8192 + it.t_lo * 64 + vdc * 8;
#define A_GLOAD(S, t_) do { \
    if ((t_) == it.n_loc) { ld_ = it.ldkc; vld_ = 512; kp_ = it.kc + (size_t)krow * it.ldkc + kdc * 8; vp_ = it.vtc + (size_t)vrow * 512 + vdc * 8; } \
    S##k0 = *reinterpret_cast<const uint4*>(kp_); S##k1 = *reinterpret_cast<const uint4*>(kp_ + (size_t)KRS * ld_); \
    if (NKC > 2) { S##k2 = *reinterpret_cast<const uint4*>(kp_ + (size_t)2 * KRS * ld_); S##k3 = *reinterpret_cast<const uint4*>(kp_ + (size_t)3 * KRS * ld_); } \
    S##v0 = *reinterpret_cast<const uint4*>(vp_); S##v1 = *reinterpret_cast<const uint4*>(vp_ + (size_t)32 * vld_); \
    if (NVC > 2) { S##v2 = *reinterpret_cast<const uint4*>(vp_ + (size_t)64 * vld_); S##v3 = *reinterpret_cast<const uint4*>(vp_ + (size_t)96 * vld_); } \
    kp_ += (size_t)64 * ld_; vp_ += 64; \
  } while (0)
#define A_LSTORE(S, buf_) do { \
      u16* kd = Ks + (buf_) * BUFE + krow * KLD + kdc * 8; \
      *reinterpret_cast<uint4*>(kd) = S##k0; *reinterpret_cast<uint4*>(kd + KRS * KLD) = S##k1; \
      if (NKC > 2) { *reinterpret_cast<uint4*>(kd + 2 * KRS * KLD) = S##k2; *reinterpret_cast<uint4*>(kd + 3 * KRS * KLD) = S##k3; } \
      u16* vd = Vt + (buf_) * BUFE + vrow * 80 + vdc * 8; \
      *reinterpret_cast<uint4*>(vd) = S##v0; *reinterpret_cast<uint4*>(vd + 32 * 80) = S##v1; \
      if (NVC > 2) { *reinterpret_cast<uint4*>(vd + 64 * 80) = S##v2; *reinterpret_cast<uint4*>(vd + 96 * 80) = S##v3; } \
    } while (0)
  constexpr int BUFE = 64 * KLD + NDV * 16 * 80;
  constexpr float SC = 0.125f * 1.4426950408889634f;
  constexpr bool PAIR = DIST2;
  constexpr int NKB = PAIR ? 8 : 4;
  const int niter = PAIR ? (ntile + 1) / 2 : ntile;
  A_GLOAD(p, 0);
  if (PAIR) { if (ntile > 1) A_GLOAD(q, 1); }
  __syncthreads();
  A_LSTORE(p, 0);
  if (PAIR) { if (ntile > 1) A_LSTORE(q, 1); }
  __syncthreads();
  if (PAIR) { if (ntile > 2) A_GLOAD(p, 2); if (ntile > 3) A_GLOAD(q, 3); } else { if (ntile > 1) A_GLOAD(p, 1); }
  for (int itn = 0; itn < niter; ++itn) {
    const int t = PAIR ? 2 * itn : itn;
    const bool two = PAIR && (t + 1 < ntile);
    const u16* Kb0 = Ks + (PAIR ? 0 : (t & 1)) * BUFE;
    const u16* Vb0 = Vt + (PAIR ? 0 : (t & 1)) * BUFE;
    const u16* Kb1 = Ks + BUFE;
    const u16* Vb1 = Vt + BUFE;
    f32x4 S[2][NKB];
#pragma unroll
    for (int nq = 0; nq < 2; ++nq)
#pragma unroll
      for (int kb = 0; kb < NKB; ++kb) S[nq][kb] = zero4();
    __builtin_amdgcn_s_setprio(1);
#pragma unroll
    for (int kb = 0; kb < 4; ++kb)
#pragma unroll
      for (int ks = 0; ks < 2; ++ks) {
        const bf16x8 kf = ldf(Kb0 + (kb * 16 + l16) * KLD + koff + ks * 32 + quad * 8);
        S[0][kb] = mfma(kf, qf[0][ks], S[0][kb]);
        S[1][kb] = mfma(kf, qf[1][ks], S[1][kb]);
      }
    if (PAIR) {
      if (two) {
#pragma unroll
        for (int kb = 0; kb < 4; ++kb)
#pragma unroll
          for (int ks = 0; ks < 2; ++ks) {
            const bf16x8 kf = ldf(Kb1 + (kb * 16 + l16) * KLD + koff + ks * 32 + quad * 8);
            S[0][NKB - 4 + kb] = mfma(kf, qf[0][ks], S[0][NKB - 4 + kb]);
            S[1][NKB - 4 + kb] = mfma(kf, qf[1][ks], S[1][NKB - 4 + kb]);
          }
      } else {
#pragma unroll
        for (int kb = 0; kb < 4; ++kb) {
          f32x4 neg = {-1e30f, -1e30f, -1e30f, -1e30f};
          S[0][NKB - 4 + kb] = neg; S[1][NKB - 4 + kb] = neg;
        }
      }
    }
    __builtin_amdgcn_s_setprio(0);
    const bool mask0 = it.mask && (t < it.n_loc);
    const bool mask1 = PAIR && it.mask && (t + 1 < it.n_loc);
    const int key00 = (it.t_lo + t) * 64;
    bf16x8 P[2][NKB / 2];
#pragma unroll
    for (int nq = 0; nq < 2; ++nq) {
      float mx = -1e30f;
      const int qi = qi0 + nq * 16 + l16;
#pragma unroll
      for (int kb = 0; kb < NKB; ++kb)
#pragma unroll
        for (int j = 0; j < 4; ++j) {
          float v = S[nq][kb][j];
          if (kb < 4 ? mask0 : mask1) {
            const int d = (key00 + kb * 16 + quad * 4 + j) - qi;
            if (d > 128 || d < -128) v = -1e30f;
            S[nq][kb][j] = v;
          }
          mx = fmaxf(mx, v);
        }
      mx = fmaxf(mx, __shfl_xor(mx, 16));
      mx = fmaxf(mx, __shfl_xor(mx, 32));
      const float mnew = fmaxf(mrun[nq], mx);
      const float alpha = __builtin_amdgcn_exp2f((mrun[nq] - mnew) * SC);
      const float mb = -mnew * SC;
      mrun[nq] = mnew;
      float ls = 0.f;
#pragma unroll
      for (int kb = 0; kb < NKB; ++kb)
#pragma unroll
        for (int j = 0; j < 4; ++j) { const float pe = __builtin_amdgcn_exp2f(fmaf(S[nq][kb][j], SC, mb)); S[nq][kb][j] = pe; ls += pe; }
      lrun[nq] = lrun[nq] * alpha + ls;
#pragma unroll
      for (int dvb = 0; dvb < NDV; ++dvb) { O[dvb][nq][0] *= alpha; O[dvb][nq][1] *= alpha; O[dvb][nq][2] *= alpha; O[dvb][nq][3] *= alpha; }
#pragma unroll
      for (int ks = 0; ks < NKB / 2; ++ks) {
        uint4 u;
        u.x = pack2(S[nq][2 * ks][0], S[nq][2 * ks][1]); u.y = pack2(S[nq][2 * ks][2], S[nq][2 * ks][3]);
        u.z = pack2(S[nq][2 * ks + 1][0], S[nq][2 * ks + 1][1]); u.w = pack2(S[nq][2 * ks + 1][2], S[nq][2 * ks + 1][3]);
        P[nq][ks] = __builtin_bit_cast(bf16x8, u);
      }
    }
    if (!PAIR) {
      if (t + 1 < ntile) {
        A_LSTORE(p, (t + 1) & 1);
        if (t + 2 < ntile) A_GLOAD(p, t + 2);
      }
    }
    __builtin_amdgcn_s_setprio(1);
#pragma unroll
    for (int dvb = 0; dvb < NDV; ++dvb)
#pragma unroll
      for (int ks = 0; ks < 2; ++ks) {
        const bf16x8 vf = ldf(Vb0 + (dvb * 16 + l16) * 80 + ks * 32 + quad * 8);
        O[dvb][0] = mfma(vf, P[0][ks], O[dvb][0]);
        O[dvb][1] = mfma(vf, P[1][ks], O[dvb][1]);
      }
    if (PAIR) {
      if (two) {
#pragma unroll
        for (int dvb = 0; dvb < NDV; ++dvb)
#pragma unroll
          for (int ks = 0; ks < 2; ++ks) {
            const bf16x8 vf = ldf(Vb1 + (dvb * 16 + l16) * 80 + ks * 32 + quad * 8);
            O[dvb][0] = mfma(vf, P[0][NKB / 2 - 2 + ks], O[dvb][0]);
            O[dvb][1] = mfma(vf, P[1][NKB / 2 - 2 + ks], O[dvb][1]);
          }
      }
      __builtin_amdgcn_s_setprio(0);
      if (itn + 1 < niter) {
        __syncthreads();
        A_LSTORE(p, 0);
        if (t + 3 < ntile) A_LSTORE(q, 1);
        __syncthreads();
        if (t + 4 < ntile) A_GLOAD(p, t + 4);
        if (t + 5 < ntile) A_GLOAD(q, t + 5);
      }
    } else {
      __builtin_amdgcn_s_setprio(0);
      if (t + 1 < ntile) __syncthreads();
    }
  }
}
#undef A_LSTORE
#undef A_GLOAD
DI void attn_a_phase(const Params& p, char* smem, int layer) {
  const int tid = threadIdx.x, lane = tid & 63, w = tid >> 6, l16 = lane & 15, quad = lane >> 4;
  const u16* PR = (const u16*)(p.ws + OFF_PR);
  const u16* VT = (const u16*)(p.ws + OFF_VT);
  u16* OG = (u16*)(p.ws + OFF_H);
  const float* sink = p.in[lbase(layer) + 5];
  const u16* CK = (const u16*)(p.ws + (layer == 0 ? OFF_CK0 : OFF_CK3));
  const u16* CV = (const u16*)(p.ws + (layer == 0 ? OFF_CV0 : OFF_CV3));
  for (int itx0 = blockIdx.x; itx0 < 1024; itx0 += gridDim.x) {
    const bool lat = itx0 < 512;
    const int v0 = lat ? itx0 : itx0 - 512;
    const int itx = (v0 & 7) * 64 + (v0 >> 3);
    int qt, hkv, b, seq_row;
    AttnItem it;
    if (lat) {
      qt = itx & 31; hkv = (itx >> 5) & 3; b = itx >> 7; seq_row = 4096 + b * 1024;
      const int q0 = qt * 32;
      it.t_lo = (q0 >= 128 ? q0 - 128 : 0) >> 6;
      int t_hi = (q0 + 159) >> 6; if (t_hi > 15) t_hi = 15;
      it.n_loc = t_hi - it.t_lo + 1; it.mask = 1; it.n_cache = 8;
      it.kc = CK + (size_t)b * 512 * 256 + hkv * 64; it.ldkc = 256;
      it.vtc = CV + (size_t)(b * 256 + hkv * 64) * 512;
    } else {
      const int id = itx;
      qt = id & 7; hkv = (id >> 3) & 3; b = id >> 5; seq_row = b * 256;
      it.t_lo = 0; it.n_loc = 4; it.mask = 0; it.n_cache = 0; it.kc = nullptr; it.ldkc = 0; it.vtc = nullptr;
    }
    it.kb = PR + (size_t)seq_row * 2560 + 1024 + hkv * 64; it.ldk = 2560;
    it.vtb = VT + (size_t)(hkv * 64) * 8192 + seq_row;
    const int hq = hkv * 4 + w;
    bf16x8 qf[2][2];
#pragma unroll
    for (int nq = 0; nq < 2; ++nq) {
      const u16* qp = PR + (size_t)(seq_row + qt * 32 + nq * 16 + l16) * 2560 + hq * 64 + quad * 8;
      qf[nq][0] = ldf(qp); qf[nq][1] = ldf(qp + 32);
    }
    f32x4 O[4][2];
    float mrun[2], lrun[2];
    const float sk = sink[hq];
#pragma unroll
    for (int nq = 0; nq < 2; ++nq) { mrun[nq] = sk * 8.f; lrun[nq] = (quad == 0) ? 1.f : 0.f; }
#pragma unroll
    for (int d = 0; d < 4; ++d) { O[d][0] = zero4(); O[d][1] = zero4(); }
    attn_core<64, 4>(smem, it, qf, 0, qt * 32, O, mrun, lrun);
#pragma unroll
    for (int nq = 0; nq < 2; ++nq) {
      float l = lrun[nq]; l += __shfl_xor(l, 16); l += __shfl_xor(l, 32);
      const float inv = 1.f / l;
      const int row = seq_row + qt * 32 + nq * 16 + l16;
#pragma unroll
      for (int dvb = 0; dvb < 4; ++dvb) {
        const int col = hq * 64 + dvb * 16 + quad * 4;
        const uint2 zz = *reinterpret_cast<const uint2*>(PR + (size_t)row * 2560 + 1536 + col);
        const float z0 = bf2f((u16)(zz.x & 0xffff)), z1 = bf2f((u16)(zz.x >> 16)), z2 = bf2f((u16)(zz.y & 0xffff)), z3 = bf2f((u16)(zz.y >> 16));
        uint2 o;
        o.x = pack2(O[dvb][nq][0] * inv * silu(z0), O[dvb][nq][1] * inv * silu(z1));
        o.y = pack2(O[dvb][nq][2] * inv * silu(z2), O[dvb][nq][3] * inv * silu(z3));
        *reinterpret_cast<uint2*>(OG + (size_t)row * 1024 + col) = o;
      }
    }
  }
}

DI void attn_b_phase(const Params& p, char* smem) {
  const int tid = threadIdx.x, lane = tid & 63, w = tid >> 6, l16 = lane & 15, quad = lane >> 4;
  const int comp = w & 1, qh = w >> 1;
  const u16* PR = (const u16*)(p.ws + OFF_PR);
  const u16* VT = (const u16*)(p.ws + OFF_VT);
  u16* OG = (u16*)(p.ws + OFF_H);
  const float* LAM = (const float*)(p.ws + OFF_LAM);
  const float lam = LAM[0], lam_init = LAM[1];
  const float* subw = p.in[26];
  const u16* CK = (const u16*)(p.ws + OFF_CK1);
  const u16* CV = (const u16*)(p.ws + OFF_CV1);
  float4* Ox = (float4*)smem;
  for (int itx0 = blockIdx.x; itx0 < 1024; itx0 += gridDim.x) {
    const bool lat = itx0 < 512;
    const int v0 = lat ? itx0 : itx0 - 512;
    const int itx = (v0 & 7) * 64 + (v0 >> 3);
    int qt, h, b, seq_row;
    AttnItem it;
    if (lat) {
      qt = itx & 15; h = (itx >> 4) & 7; b = itx >> 7; seq_row = 4096 + b * 1024; it.n_loc = 16; it.n_cache = 8;
      it.kc = CK + (size_t)b * 512 * 1024 + h * 128; it.ldkc = 1024;
      it.vtc = CV + (size_t)(b * 1024 + h * 128) * 512;
    } else {
      const int id = itx; qt = id & 3; h = (id >> 2) & 7; b = id >> 5; seq_row = b * 256; it.n_loc = 4; it.n_cache = 0;
      it.kc = nullptr; it.ldkc = 0; it.vtc = nullptr;
    }
    it.t_lo = 0; it.mask = 0;
    it.kb = PR + (size_t)seq_row * 4096 + 1024 + h * 128; it.ldk = 4096;
    it.vtb = VT + (size_t)(h * 128) * 8192 + seq_row;
    bf16x8 qf[2][2];
#pragma unroll
    for (int nq = 0; nq < 2; ++nq) {
      const u16* qp = PR + (size_t)(seq_row + qt * 64 + qh * 32 + nq * 16 + l16) * 4096 + h * 128 + comp * 64 + quad * 8;
      qf[nq][0] = ldf(qp); qf[nq][1] = ldf(qp + 32);
    }
    f32x4 O[8][2];
    float mrun[2], lrun[2];
#pragma unroll
    for (int nq = 0; nq < 2; ++nq) { mrun[nq] = -1e30f; lrun[nq] = 0.f; }
#pragma unroll
    for (int d = 0; d < 8; ++d) { O[d][0] = zero4(); O[d][1] = zero4(); }
    attn_core<128, 8>(smem, it, qf, comp * 64, qt * 64 + qh * 32, O, mrun, lrun);
    float inv[2];
#pragma unroll
    for (int nq = 0; nq < 2; ++nq) { float l = lrun[nq]; l += __shfl_xor(l, 16); l += __shfl_xor(l, 32); inv[nq] = 1.f / l; }
    __syncthreads();
    if (comp == 1) {
#pragma unroll
      for (int d = 0; d < 8; ++d)
#pragma unroll
        for (int nq = 0; nq < 2; ++nq) {
          float4 v; v.x = O[d][nq][0] * inv[nq]; v.y = O[d][nq][1] * inv[nq]; v.z = O[d][nq][2] * inv[nq]; v.w = O[d][nq][3] * inv[nq];
          Ox[((qh * 8 + d) * 2 + nq) * 64 + lane] = v;
        }
    }
    __syncthreads();
    if (comp == 0) {
#pragma unroll
      for (int nq = 0; nq < 2; ++nq) {
        float ss = 0.f;
#pragma unroll
        for (int d = 0; d < 8; ++d) {
          const float4 o1 = Ox[((qh * 8 + d) * 2 + nq) * 64 + lane];
          const float d0 = O[d][nq][0] * inv[nq] - lam * o1.x, d1 = O[d][nq][1] * inv[nq] - lam * o1.y;
          const float d2 = O[d][nq][2] * inv[nq] - lam * o1.z, d3 = O[d][nq][3] * inv[nq] - lam * o1.w;
          O[d][nq][0] = d0; O[d][nq][1] = d1; O[d][nq][2] = d2; O[d][nq][3] = d3;
          ss += d0 * d0 + d1 * d1 + d2 * d2 + d3 * d3;
        }
        ss += __shfl_xor(ss, 16); ss += __shfl_xor(ss, 32);
        const float rs = rsqrtf(ss * (1.f / 128.f) + NORM_EPS) * (1.f - lam_init);
        const int row = seq_row + qt * 64 + qh * 32 + nq * 16 + l16;
#pragma unroll
        for (int d = 0; d < 8; ++d) {
          const int e0 = d * 16 + quad * 4;
          const int col = h * 128 + e0;
          const uint2 zz = *reinterpret_cast<const uint2*>(PR + (size_t)row * 4096 + 3072 + col);
          const float z0 = bf2f((u16)(zz.x & 0xffff)), z1 = bf2f((u16)(zz.x >> 16)), z2 = bf2f((u16)(zz.y & 0xffff)), z3 = bf2f((u16)(zz.y >> 16));
          const float4 sw = *reinterpret_cast<const float4*>(subw + e0);
          uint2 o;
          o.x = pack2(O[d][nq][0] * rs * sw.x * silu(z0), O[d][nq][1] * rs * sw.y * silu(z1));
          o.y = pack2(O[d][nq][2] * rs * sw.z * silu(z2), O[d][nq][3] * rs * sw.w * silu(z3));
          *reinterpret_cast<uint2*>(OG + (size_t)row * 1024 + col) = o;
        }
      }
    }
  }
}

DI void unpack8(const uint4 v, float (&f)[8]) {
  f[0] = bf2f((u16)(v.x & 0xffff)); f[1] = bf2f((u16)(v.x >> 16)); f[2] = bf2f((u16)(v.y & 0xffff)); f[3] = bf2f((u16)(v.y >> 16));
  f[4] = bf2f((u16)(v.z & 0xffff)); f[5] = bf2f((u16)(v.z >> 16)); f[6] = bf2f((u16)(v.w & 0xffff)); f[7] = bf2f((u16)(v.w >> 16));
}
DI void dn_conv_phase(const Params& p) {
  const int lane = threadIdx.x & 63, w = threadIdx.x >> 6, l16 = lane & 15, gsub = lane >> 4;
  const u16* PR = (const u16*)(p.ws + OFF_PR);
  const float* cw = p.in[32];
  const float* GATES = (const float*)(p.ws + OFF_GATES);
  float* GB = (float*)(p.ws + OFF_GB);
  constexpr int NCONV = 1024 * 6, NGATE = 512;
  for (int task = blockIdx.x * 4 + w; task < NCONV + NGATE; task += gridDim.x * 4) {
    if (task >= NCONV) {
      const int row0 = (task - NCONV) * 16;
      const u16* HR = (const u16*)(p.ws + OFF_HR);
      const u16* WG = (const u16*)(p.ws + OFF_WTIN + WTIN_L2) + (size_t)4096 * 1024;
      const int quad = lane >> 4;
      const u16* ap = HR + (size_t)(row0 + l16) * 1024 + quad * 8;
      const u16* bp0 = WG + (size_t)l16 * 1024 + quad * 8;
      const u16* bp1 = WG + (size_t)(16 + l16) * 1024 + quad * 8;
      f32x4 g0 = zero4(), g1 = zero4();
#pragma unroll 8
      for (int ks = 0; ks < 32; ++ks) {
        const bf16x8 a = ldf(ap + ks * 32), b0 = ldf(bp0 + ks * 32), b1 = ldf(bp1 + ks * 32);
        g0 = mfma(a, b0, g0);
        g1 = mfma(a, b1, g1);
      }
      const int cond = row0 < 4096 ? 0 : 1 + ((row0 - 4096) >> 10);
      const float* SS = (const float*)(p.ws + OFF_SS) + 2 * 8192;
      const float* SWg = (const float*)(p.ws + OFF_SW) + (size_t)(2 * 5 + cond) * 4224 + 4096;
      const float sw0 = SWg[l16], sw1 = SWg[16 + l16];
      const float dtb = p.in[34][l16], ea = expf(p.in[33][l16]);
#pragma unroll
      for (int r = 0; r < 4; ++r) {
        const int row = row0 + quad * 4 + r;
        const float rs = rsqrtf(SS[row] * (1.f / 1024.f) + NORM_EPS);
        const float raw_b = rs * g0[r] + sw0, raw_a = rs * g1[r] + sw1;
        GB[(size_t)row * 32 + l16] = 1.f / (1.f + expf(-raw_b));
        const float x = raw_a + dtb;
        const float sp = fmaxf(x, 0.f) + log1pf(expf(-fabsf(x)));
        GB[(size_t)row * 32 + 16 + l16] = -ea * sp;
      }
      continue;
    }
    const int strip = task / 6, g4 = task - strip * 6;
    const int g = g4 * 4 + gsub;
    const int r0 = strip * 8;
    int t0, L;
    if (r0 < 4096) { t0 = r0 & 255; L = 256; } else { t0 = (r0 - 4096) & 1023; L = 1024; }
    const int ch = g * 128 + l16 * 8;
    const u16* src = PR + (size_t)r0 * 4224 + ch;
    uint4 rows[10];
    const uint4 z4 = make_uint4(0u, 0u, 0u, 0u);
    rows[0] = (t0 > 0) ? *reinterpret_cast<const uint4*>(src - 4224) : z4;
#pragma unroll
    for (int i = 0; i < 8; ++i) rows[i + 1] = *reinterpret_cast<const uint4*>(src + (size_t)i * 4224);
    rows[9] = (t0 + 8 < L) ? *reinterpret_cast<const uint4*>(src + (size_t)8 * 4224) : z4;
    float w0[8], w1[8], w2[8];
#pragma unroll
    for (int k = 0; k < 2; ++k) {
      const float4 a = *reinterpret_cast<const float4*>(cw + ch + k * 4), b = *reinterpret_cast<const float4*>(cw + 3072 + ch + k * 4), c = *reinterpret_cast<const float4*>(cw + 6144 + ch + k * 4);
      w0[k * 4] = a.x; w0[k * 4 + 1] = a.y; w0[k * 4 + 2] = a.z; w0[k * 4 + 3] = a.w;
      w1[k * 4] = b.x; w1[k * 4 + 1] = b.y; w1[k * 4 + 2] = b.z; w1[k * 4 + 3] = b.w;
      w2[k * 4] = c.x; w2[k * 4 + 1] = c.y; w2[k * 4 + 2] = c.z; w2[k * 4 + 3] = c.w;
    }
    u16* dstb = (u16*)(p.ws + (g < 8 ? OFF_QN : (g < 16 ? OFF_KN : OFF_VV))) + (size_t)r0 * 1024 + (g & 7) * 128 + l16 * 8;
    float fm[8], f0[8], fp[8];
    unpack8(rows[0], fm); unpack8(rows[1], f0);
#pragma unroll
    for (int i = 0; i < 8; ++i) {
      unpack8(rows[i + 2], fp);
      float y[8];
      float ss = 0.f;
#pragma unroll
      for (int k = 0; k < 8; ++k) { y[k] = silu(w0[k] * fm[k] + w1[k] * f0[k] + w2[k] * fp[k]); ss += y[k] * y[k]; }
      if (g < 16) {
        ss = grp16_sum(ss);
        float sc = rsqrtf(ss + 1e-6f);
        if (g < 8) sc *= 0.08838834764831845f;
#pragma unroll
        for (int k = 0; k < 8; ++k) y[k] *= sc;
      }
      uint4 o; o.x = pack2(y[0], y[1]); o.y = pack2(y[2], y[3]); o.z = pack2(y[4], y[5]); o.w = pack2(y[6], y[7]);
      *reinterpret_cast<uint4*>(dstb + (size_t)i * 1024) = o;
#pragma unroll
      for (int k = 0; k < 8; ++k) { fm[k] = f0[k]; f0[k] = fp[k]; }
    }
  }
}

struct SeqInfo { int base_row, L, nc, gc_base; };
DI SeqInfo seq_info(int seq) {
  SeqInfo s;
  if (seq < 16) { s.base_row = seq * 256; s.L = 256; s.nc = 4; s.gc_base = seq * 4; }
  else { s.base_row = 4096 + (seq - 16) * 1024; s.L = 1024; s.nc = 16; s.gc_base = 64 + (seq - 16) * 16; }
  return s;
}

DI void dn_chunk_phase(const Params& p, char* smem) {
  const int lane = threadIdx.x & 63, w = threadIdx.x >> 6, l16 = lane & 15, quad = lane >> 4;
  float* Lw = (float*)smem + w * (64 * 68);
  const u16* KN = (const u16*)(p.ws + OFF_KN);
  const float* GB = (const float*)(p.ws + OFF_GB);
  u16* TM = (u16*)(p.ws + OFF_TM);
  for (int tk = blockIdx.x * 4 + w; tk < 2048; tk += gridDim.x * 4) {
    const int dir = tk & 1, h = (tk >> 1) & 7, gc = tk >> 4;
    int base_row, L, c;
    if (gc < 64) { base_row = (gc >> 2) * 256; L = 256; c = gc & 3; }
    else { const int lc = gc - 64; base_row = 4096 + (lc >> 4) * 1024; L = 1024; c = lc & 15; }
    const int p0 = c * 64;
    const int tok_i = base_row + (dir ? (L - 1 - (p0 + lane)) : (p0 + lane));
    const float beta_i = GB[(size_t)tok_i * 32 + dir * 8 + h];
    float gcum = GB[(size_t)tok_i * 32 + 16 + dir * 8 + h];
#pragma unroll
    for (int o = 1; o < 64; o <<= 1) { float t = __shfl_up(gcum, o); if (lane >= o) gcum += t; }
    bf16x8 f[4][4];
#pragma unroll
    for (int mb = 0; mb < 4; ++mb) {
      const int pi = p0 + mb * 16 + l16;
      const int tok = base_row + (dir ? (L - 1 - pi) : pi);
#pragma unroll
      for (int ks = 0; ks < 4; ++ks) f[mb][ks] = ldf(KN + (size_t)tok * 1024 + h * 128 + ks * 32 + quad * 8);
    }
#pragma unroll
    for (int mb = 0; mb < 4; ++mb)
#pragma unroll
      for (int nb = 0; nb <= mb; ++nb) {
        f32x4 a = zero4();
#pragma unroll
        for (int ks = 0; ks < 4; ++ks) a = mfma(f[mb][ks], f[nb][ks], a);
        const int jj = nb * 16 + l16;
        const float gj = __shfl(gcum, jj);
#pragma unroll
        for (int j = 0; j < 4; ++j) {
          const int i = mb * 16 + quad * 4 + j;
          const float gi = __shfl(gcum, i), bi = __shfl(beta_i, i);
          Lw[i * 68 + jj] = (i > jj) ? bi * a[j] * __expf(gi - gj) : 0.f;
        }
      }
    __builtin_amdgcn_fence(__ATOMIC_RELEASE, "wavefront");
    __builtin_amdgcn_s_waitcnt(0xc07f);
    __builtin_amdgcn_wave_barrier();
    float t[64];
    u16* Tout = TM + (size_t)((dir * 8 + h) * 128 + gc) * 4096;
#pragma unroll
    for (int i = 0; i < 64; ++i) {
      float a = (i == lane) ? 1.f : 0.f;
#pragma unroll
      for (int j4 = 0; j4 < (i + 3) / 4; ++j4) {
        const float4 lv = *reinterpret_cast<const float4*>(Lw + i * 68 + j4 * 4);
        if (j4 * 4 + 0 < i) a -= lv.x * t[j4 * 4 + 0];
        if (j4 * 4 + 1 < i) a -= lv.y * t[j4 * 4 + 1];
        if (j4 * 4 + 2 < i) a -= lv.z * t[j4 * 4 + 2];
        if (j4 * 4 + 3 < i) a -= lv.w * t[j4 * 4 + 3];
      }
      t[i] = a;
      Tout[i * 64 + lane] = f2bf(a);
    }
    __builtin_amdgcn_wave_barrier();
  }
}

DI void dn_scan_task(const Params& p, char* smem, int seq, int h, int dir, int slice) {
  const int tid = threadIdx.x, lane = tid & 63, w = tid >> 6, l16 = lane & 15, quad = lane >> 4;
  u16* Ks = (u16*)smem;
  u16* Sb = Ks + 2 * 64 * 136;
  u16* Rt = Sb + 32 * 136;
  u16* Vn = Rt + 32 * 80;
  u16* Vs = Vn + 32 * 80;
  u16* Pl = Vs + 32 * 80;
  float* sg = (float*)(Pl + 64 * 80);
  float* sbt = sg + 128;
  const u16* QN = (const u16*)(p.ws + OFF_QN);
  const u16* KN = (const u16*)(p.ws + OFF_KN);
  const u16* VV = (const u16*)(p.ws + OFF_VV);
  const float* GB = (const float*)(p.ws + OFF_GB);
  const u16* TM = (const u16*)(p.ws + OFF_TM);
  u16* OFB = (u16*)(p.ws + OFF_OFB) + (size_t)dir * 8192 * 1024;
  const SeqInfo si = seq_info(seq);
  f32x4 Sacc[2][2];
  if (seq >= 16) {
    const float* s0 = p.in[6] + (size_t)(((seq - 16) * 2 + dir) * 8 + h) * 16384;
#pragma unroll
    for (int mb2 = 0; mb2 < 2; ++mb2)
#pragma unroll
      for (int nb = 0; nb < 2; ++nb)
#pragma unroll
        for (int j = 0; j < 4; ++j) Sacc[mb2][nb][j] = s0[(size_t)(32 * w + mb2 * 16 + quad * 4 + j) * 128 + slice * 32 + nb * 16 + l16];
  } else {
#pragma unroll
    for (int mb2 = 0; mb2 < 2; ++mb2)
#pragma unroll
      for (int nb = 0; nb < 2; ++nb) Sacc[mb2][nb] = zero4();
  }
  __syncthreads();
#pragma unroll
  for (int mb2 = 0; mb2 < 2; ++mb2)
#pragma unroll
    for (int nb = 0; nb < 2; ++nb) {
      uint2 pk; pk.x = pack2(Sacc[mb2][nb][0], Sacc[mb2][nb][1]); pk.y = pack2(Sacc[mb2][nb][2], Sacc[mb2][nb][3]);
      *reinterpret_cast<uint2*>(Sb + (nb * 16 + l16) * 136 + 32 * w + mb2 * 16 + quad * 4) = pk;
    }
  uint4 nk0, nk1, nk2, nk3; float ngr = 0.f, nbe = 0.f; bf16x8 nq0, nq1, nq2, nq3, nt0, nt1; u16 nv[2][4];
  const int krow = lane, kdc0 = 4 * w;
#define SCAN_TOK(pi_) (si.base_row + (dir ? (si.L - 1 - (pi_)) : (pi_)))
#define SCAN_FETCH(c_) do { \
    const int q0_ = (c_) * 64; \
    { const u16* kp_ = KN + (size_t)SCAN_TOK(q0_ + krow) * 1024 + h * 128 + kdc0 * 8; \
      nk0 = *reinterpret_cast<const uint4*>(kp_); nk1 = *reinterpret_cast<const uint4*>(kp_ + 8); \
      nk2 = *reinterpret_cast<const uint4*>(kp_ + 16); nk3 = *reinterpret_cast<const uint4*>(kp_ + 24); } \
    if (w == 0) { const int tk_ = SCAN_TOK(q0_ + lane); ngr = GB[(size_t)tk_ * 32 + 16 + dir * 8 + h]; nbe = GB[(size_t)tk_ * 32 + dir * 8 + h]; } \
    { const u16* qp_ = QN + (size_t)SCAN_TOK(q0_ + 16 * w + l16) * 1024 + h * 128 + quad * 8; \
      nq0 = ldf(qp_); nq1 = ldf(qp_ + 32); nq2 = ldf(qp_ + 64); nq3 = ldf(qp_ + 96); } \
    { const u16* tp_ = TM + (size_t)((dir * 8 + h) * 128 + si.gc_base + (c_)) * 4096 + (16 * w + l16) * 64 + quad * 8; \
      nt0 = ldf(tp_); nt1 = ldf(tp_ + 32); } \
    _Pragma("unroll") for (int j = 0; j < 4; ++j) { \
      const u16* vp_ = VV + (size_t)SCAN_TOK(q0_ + 16 * w + quad * 4 + j) * 1024 + h * 128 + slice * 32 + l16; \
      nv[0][j] = vp_[0]; nv[1][j] = vp_[16]; } \
  } while (0)
#define SCAN_KST(v_, i_, b_) do { \
    *reinterpret_cast<uint4*>(Ks + (b_) * 8704 + krow * 136 + (kdc0 + (i_)) * 8) = v_; \
  } while (0)
#define SCAN_STAGE(b_) do { \
    SCAN_KST(nk0, 0, b_); SCAN_KST(nk1, 1, b_); SCAN_KST(nk2, 2, b_); SCAN_KST(nk3, 3, b_); \
    if (w == 0) { \
      float gcum_ = ngr; \
      _Pragma("unroll") for (int o = 1; o < 64; o <<= 1) { float t_ = __shfl_up(gcum_, o); if (lane >= o) gcum_ += t_; } \
      sg[(b_) * 64 + lane] = gcum_; \
      sbt[(b_) * 64 + lane] = nbe; \
    } \
  } while (0)
  SCAN_FETCH(0);
  SCAN_STAGE(0);
  for (int c = 0; c < si.nc; ++c) {
    __syncthreads();
    const int p0 = c * 64;
    const u16* Kc = Ks + (c & 1) * 8704;
    const float* sgc = sg + (c & 1) * 64;
    const float* sbc = sbt + (c & 1) * 64;
    bf16x8 qf[4], tf[2];
    qf[0] = nq0; qf[1] = nq1; qf[2] = nq2; qf[3] = nq3; tf[0] = nt0; tf[1] = nt1;
    float vv[2][4];
#pragma unroll
    for (int j = 0; j < 4; ++j) { vv[0][j] = bf2f(nv[0][j]); vv[1][j] = bf2f(nv[1][j]); }
    if (c + 1 < si.nc) SCAN_FETCH(c + 1);
    f32x4 QS[2], KS[2];
#pragma unroll
    for (int nb = 0; nb < 2; ++nb) { QS[nb] = zero4(); KS[nb] = zero4(); }
#pragma unroll
    for (int ks = 0; ks < 4; ++ks) {
      const bf16x8 kfr = ldf(Kc + (16 * w + l16) * 136 + ks * 32 + quad * 8);
#pragma unroll
      for (int nb = 0; nb < 2; ++nb) {
        bf16x8 sf = ldf(Sb + (nb * 16 + l16) * 136 + ks * 32 + quad * 8);
        QS[nb] = mfma(qf[ks], sf, QS[nb]);
        KS[nb] = mfma(kfr, sf, KS[nb]);
      }
    }
    float gi[4], bi[4], egi[4];
    const float glast = sgc[63];
#pragma unroll
    for (int j = 0; j < 4; ++j) { gi[j] = sgc[16 * w + quad * 4 + j]; bi[j] = sbc[16 * w + quad * 4 + j]; egi[j] = __expf(gi[j]); }
#pragma unroll
    for (int nb = 0; nb < 2; ++nb) {
      float r0 = bi[0] * (vv[nb][0] - egi[0] * KS[nb][0]);
      float r1 = bi[1] * (vv[nb][1] - egi[1] * KS[nb][1]);
      float r2 = bi[2] * (vv[nb][2] - egi[2] * KS[nb][2]);
      float r3 = bi[3] * (vv[nb][3] - egi[3] * KS[nb][3]);
      uint2 pk; pk.x = pack2(r0, r1); pk.y = pack2(r2, r3);
      *reinterpret_cast<uint2*>(Rt + (nb * 16 + l16) * 80 + 16 * w + quad * 4) = pk;
    }
    bf16x8 Pf[2];
    {
      const int icol = 16 * w + l16;
      const float gic = sgc[icol];
      f32x4 pt[4];
#pragma unroll
      for (int nb4 = 0; nb4 < 4; ++nb4) {
        pt[nb4] = zero4();
        if (nb4 <= w) {
#pragma unroll
          for (int ks = 0; ks < 4; ++ks) pt[nb4] = mfma(ldf(Kc + (nb4 * 16 + l16) * 136 + ks * 32 + quad * 8), qf[ks], pt[nb4]);
        }
        const float4 gj4 = *reinterpret_cast<const float4*>(sgc + nb4 * 16 + quad * 4);
        const int jj0 = nb4 * 16 + quad * 4;
        pt[nb4][0] = (nb4 <= w && icol >= jj0 + 0) ? pt[nb4][0] * __expf(gic - gj4.x) : 0.f;
        pt[nb4][1] = (nb4 <= w && icol >= jj0 + 1) ? pt[nb4][1] * __expf(gic - gj4.y) : 0.f;
        pt[nb4][2] = (nb4 <= w && icol >= jj0 + 2) ? pt[nb4][2] * __expf(gic - gj4.z) : 0.f;
        pt[nb4][3] = (nb4 <= w && icol >= jj0 + 3) ? pt[nb4][3] * __expf(gic - gj4.w) : 0.f;
      }
#pragma unroll
      for (int k2 = 0; k2 < 2; ++k2) {
        uint4 u;
        u.x = pack2(pt[2 * k2][0], pt[2 * k2][1]); u.y = pack2(pt[2 * k2][2], pt[2 * k2][3]);
        u.z = pack2(pt[2 * k2 + 1][0], pt[2 * k2 + 1][1]); u.w = pack2(pt[2 * k2 + 1][2], pt[2 * k2 + 1][3]);
        Pf[k2] = __builtin_bit_cast(bf16x8, u);
      }
    }
    __syncthreads();
    f32x4 VN[2];
#pragma unroll
    for (int nb = 0; nb < 2; ++nb) {
      VN[nb] = zero4();
#pragma unroll
      for (int k2 = 0; k2 < 2; ++k2) VN[nb] = mfma(tf[k2], ldf(Rt + (nb * 16 + l16) * 80 + k2 * 32 + quad * 8), VN[nb]);
      uint2 pk, ps;
      pk.x = pack2(VN[nb][0], VN[nb][1]); pk.y = pack2(VN[nb][2], VN[nb][3]);
      ps.x = pack2(VN[nb][0] * __expf(glast - gi[0]), VN[nb][1] * __expf(glast - gi[1]));
      ps.y = pack2(VN[nb][2] * __expf(glast - gi[2]), VN[nb][3] * __expf(glast - gi[3]));
      *reinterpret_cast<uint2*>(Vn + (nb * 16 + l16) * 80 + (w >> 1) * 32 + quad * 8 + (w & 1) * 4) = pk;
      *reinterpret_cast<uint2*>(Vs + (nb * 16 + l16) * 80 + 16 * w + quad * 4) = ps;
    }
    __syncthreads();
#pragma unroll
    for (int nb = 0; nb < 2; ++nb) {
      f32x4 oi = zero4();
#pragma unroll
      for (int k2 = 0; k2 < 2; ++k2)
        oi = mfma(Pf[k2], ldf(Vn + (nb * 16 + l16) * 80 + k2 * 32 + quad * 8), oi);
#pragma unroll
      for (int j = 0; j < 4; ++j) {
        const int pi = p0 + 16 * w + quad * 4 + j;
        const int tok = si.base_row + (dir ? (si.L - 1 - pi) : pi);
        OFB[(size_t)tok * 1024 + h * 128 + slice * 32 + nb * 16 + l16] = f2bf(egi[j] * QS[nb][j] + oi[j]);
      }
    }
    const float eg = __expf(glast);
    bf16x8 ktf[2][2];
    {
      typedef short s16x4_t __attribute__((ext_vector_type(4)));
      const unsigned kta = (unsigned)(size_t)(Kc + (quad * 8 + (l16 >> 2)) * 136 + 32 * w + 4 * (l16 & 3));
      s16x4_t t00l, t00h, t01l, t01h, t10l, t10h, t11l, t11h;
      asm volatile(
          "ds_read_b64_tr_b16 %0, %8\n\t"
          "ds_read_b64_tr_b16 %1, %8 offset:1088\n\t"
          "ds_read_b64_tr_b16 %2, %8 offset:8704\n\t"
          "ds_read_b64_tr_b16 %3, %8 offset:9792\n\t"
          "ds_read_b64_tr_b16 %4, %8 offset:32\n\t"
          "ds_read_b64_tr_b16 %5, %8 offset:1120\n\t"
          "ds_read_b64_tr_b16 %6, %8 offset:8736\n\t"
          "ds_read_b64_tr_b16 %7, %8 offset:9824\n\t"
          "s_waitcnt lgkmcnt(0)"
          : "=&v"(t00l), "=&v"(t00h), "=&v"(t01l), "=&v"(t01h), "=&v"(t10l), "=&v"(t10h), "=&v"(t11l), "=&v"(t11h)
          : "v"(kta) : "memory");
      ktf[0][0] = __builtin_shufflevector(t00l, t00h, 0, 1, 2, 3, 4, 5, 6, 7);
      ktf[0][1] = __builtin_shufflevector(t01l, t01h, 0, 1, 2, 3, 4, 5, 6, 7);
      ktf[1][0] = __builtin_shufflevector(t10l, t10h, 0, 1, 2, 3, 4, 5, 6, 7);
      ktf[1][1] = __builtin_shufflevector(t11l, t11h, 0, 1, 2, 3, 4, 5, 6, 7);
    }
#pragma unroll
    for (int mb2 = 0; mb2 < 2; ++mb2)
#pragma unroll
      for (int nb = 0; nb < 2; ++nb) {
        f32x4 a = Sacc[mb2][nb];
        a[0] *= eg; a[1] *= eg; a[2] *= eg; a[3] *= eg;
#pragma unroll
        for (int k2 = 0; k2 < 2; ++k2)
          a = mfma(ktf[mb2][k2], ldf(Vs + (nb * 16 + l16) * 80 + k2 * 32 + quad * 8), a);
        Sacc[mb2][nb] = a;
        uint2 pk; pk.x = pack2(a[0], a[1]); pk.y = pack2(a[2], a[3]);
        *reinterpret_cast<uint2*>(Sb + (nb * 16 + l16) * 136 + 32 * w + mb2 * 16 + quad * 4) = pk;
      }
    if (c + 1 < si.nc) SCAN_STAGE((c + 1) & 1);
  }
  if (seq < 16) {
    float* so = p.out + OUT_L2S + (size_t)((seq * 2 + dir) * 8 + h) * 16384;
#pragma unroll
    for (int mb2 = 0; mb2 < 2; ++mb2)
#pragma unroll
      for (int nb = 0; nb < 2; ++nb)
#pragma unroll
        for (int j = 0; j < 4; ++j) so[(size_t)(32 * w + mb2 * 16 + quad * 4 + j) * 128 + slice * 32 + nb * 16 + l16] = Sacc[mb2][nb][j];
  }
}

#undef SCAN_TOK
#undef SCAN_FETCH
#undef SCAN_KST
#undef SCAN_STAGE
DI void dn_scan_phase(const Params& p, char* smem) {
  for (int unit = blockIdx.x; unit < 512; unit += gridDim.x) {
    const int ntask = unit < 256 ? 1 : 4;
    for (int q = 0; q < ntask; ++q) {
      int seq, code;
      if (unit < 256) { const int u = (unit & 7) * 32 + (unit >> 3); seq = 16 + (u >> 6); code = u & 63; }
      else { const int u0 = unit - 256; const int u = (u0 & 7) * 32 + (u0 >> 3); const int ct = u * 4 + q; seq = ct >> 6; code = ct & 63; }
      dn_scan_task(p, smem, seq, (code >> 3) & 7, (code >> 2) & 1, code & 3);
    }
  }
}

DI void dn_out_phase(const Params& p) {
  const int lane = threadIdx.x & 63, w = threadIdx.x >> 6, l16 = lane & 15, hs = lane >> 4;
  const u16* OF = (const u16*)(p.ws + OFF_OFB);
  const u16* OB = OF + (size_t)8192 * 1024;
  const u16* PR = (const u16*)(p.ws + OFF_PR);
  u16* OG = (u16*)(p.ws + OFF_H);
  float gw[8];
  {
    const float4 a = *reinterpret_cast<const float4*>(p.in[35] + l16 * 8), b = *reinterpret_cast<const float4*>(p.in[35] + l16 * 8 + 4);
    gw[0] = a.x; gw[1] = a.y; gw[2] = a.z; gw[3] = a.w; gw[4] = b.x; gw[5] = b.y; gw[6] = b.z; gw[7] = b.w;
  }
  for (int task = blockIdx.x * 4 + w; task < 4096; task += gridDim.x * 4) {
    uint4 a[4], b[4], z[4];
#pragma unroll
    for (int u = 0; u < 4; ++u) {
      const int r = task * 2 + (u >> 1), h = (u & 1) * 4 + hs;
      const size_t off = (size_t)r * 1024 + h * 128 + l16 * 8;
      a[u] = *reinterpret_cast<const uint4*>(OF + off);
      b[u] = *reinterpret_cast<const uint4*>(OB + off);
      z[u] = *reinterpret_cast<const uint4*>(PR + (size_t)r * 4224 + 3072 + h * 128 + l16 * 8);
    }
#pragma unroll
    for (int u = 0; u < 4; ++u) {
      const int r = task * 2 + (u >> 1), h = (u & 1) * 4 + hs;
      float fa[8], fb[8], fz[8];
      unpack8(a[u], fa); unpack8(b[u], fb); unpack8(z[u], fz);
      float ss = 0.f;
#pragma unroll
      for (int k = 0; k < 8; ++k) { fa[k] += fb[k]; ss += fa[k] * fa[k]; }
      ss = grp16_sum(ss);
      const float rs = rsqrtf(ss * (1.f / 128.f) + NORM_EPS);
#pragma unroll
      for (int k = 0; k < 8; ++k) fa[k] = fa[k] * rs * gw[k] * silu(fz[k]);
      uint4 o; o.x = pack2(fa[0], fa[1]); o.y = pack2(fa[2], fa[3]); o.z = pack2(fa[4], fa[5]); o.w = pack2(fa[6], fa[7]);
      *reinterpret_cast<uint4*>(OG + (size_t)r * 1024 + h * 128 + l16 * 8) = o;
    }
  }
}

#define XB_TMO      128
#define XB_XCNT(j)  (256  + 64 * (j))
#define XB_XSUB(j)  (1280 + 64 * (j))
#define XB_XGEN(j)  (2304 + 64 * (j))
#define XB_TOP      3328
#define XB_TOPGEN   3392
#define XCD_BAR_WORDS 3456
#define XB_SPIN_CAP (1u << 20)
#define LAS __attribute__((address_space(3)))
DI unsigned xb_ld(unsigned* p)              { return __hip_atomic_load(p, __ATOMIC_RELAXED, __HIP_MEMORY_SCOPE_AGENT); }
DI unsigned xb_add(unsigned* p, unsigned v) { return __hip_atomic_fetch_add(p, v, __ATOMIC_RELAXED, __HIP_MEMORY_SCOPE_AGENT); }
DI unsigned xb_xcc_id() { return (unsigned)__builtin_amdgcn_s_getreg((3 << 11) | 20) & 0xFu; }
#define XB_SPIN(cond, bar) do { unsigned _sp = 0; while (cond) { __builtin_amdgcn_s_sleep(1); \
    if ((++_sp & 255u) == 0u) { if (xb_ld(&(bar)[XB_TMO])) break; if (_sp > XB_SPIN_CAP) { atomicAdd(&(bar)[XB_TMO], 1u); break; } } } } while (0)
struct XcdBarrier { unsigned* bar; unsigned x; volatile LAS unsigned* st; };
DI XcdBarrier xcd_barrier_post(unsigned* bar, volatile LAS unsigned* st) {
  XcdBarrier b; b.bar = bar; b.x = xb_xcc_id(); b.st = st;
  if (threadIdx.x == 0) (void)xb_add(&bar[XB_XCNT(b.x)], 1u);
  return b;
}
DI void xcd_barrier_complete(unsigned* bar, unsigned x, unsigned& nloc, unsigned& nx) {
  const unsigned G = gridDim.x * gridDim.y * gridDim.z;
  unsigned sum, cnt, mine, sp = 0u;
  for (;;) {
    sum = 0u; cnt = 0u; mine = 0u;
#pragma unroll
    for (unsigned j = 0; j < 16; ++j) { const unsigned c = xb_ld(&bar[XB_XCNT(j)]); sum += c; cnt += (c > 0u) ? 1u : 0u; mine = (j == x) ? c : mine; }
    if (sum == G) break;
    __builtin_amdgcn_s_sleep(1);
    if ((++sp & 255u) == 0u) { if (xb_ld(&bar[XB_TMO])) break; if (sp > XB_SPIN_CAP) { atomicAdd(&bar[XB_TMO], 1u); break; } }
  }
  nloc = mine > 0u ? mine : 1u; nx = cnt > 0u ? cnt : 1u;
}
DI void xcd_barrier(const XcdBarrier& b) {
  asm volatile("s_waitcnt vmcnt(0)" ::: "memory");
  __syncthreads();
  if (threadIdx.x == 0) {
    unsigned* bar = b.bar;
    __builtin_amdgcn_s_waitcnt(0);
    unsigned nloc = b.st[0], nx = b.st[1];
    if (nloc == 0u) { xcd_barrier_complete(bar, b.x, nloc, nx); b.st[0] = nloc; b.st[1] = nx; }
    const unsigned old = xb_add(&bar[XB_XSUB(b.x)], 1u);
    const unsigned gen = old / nloc;
    if (old + 1u == (gen + 1u) * nloc) {
      __builtin_amdgcn_fence(__ATOMIC_RELEASE, "agent");
      asm volatile("s_waitcnt vmcnt(0)" ::: "memory");
      const unsigned og = xb_add(&bar[XB_TOP], 1u);
      const unsigned tg = og / nx;
      if (og + 1u == (tg + 1u) * nx) xb_add(&bar[XB_TOPGEN], 1u);
      else XB_SPIN(xb_ld(&bar[XB_TOPGEN]) == tg, bar);
      __builtin_amdgcn_fence(__ATOMIC_ACQUIRE, "agent");
      xb_add(&bar[XB_XGEN(b.x)], 1u);
      asm volatile("s_waitcnt vmcnt(0)" ::: "memory");
    } else {
      XB_SPIN(xb_ld(&bar[XB_XGEN(b.x)]) == gen, bar);
      __builtin_amdgcn_fence(__ATOMIC_ACQUIRE, "agent");
      asm volatile("s_waitcnt vmcnt(0)" ::: "memory");
    }
  }
  __syncthreads();
}

DI void gemm_for(const Params& p, char* smem, int layer, int which) {
  const u16* H = (const u16*)(p.ws + OFF_H);
  EpiArgs e;
  const u16* WT;
  int ntn;
  e.layer = layer;
  if (which >= 1) {
    e.kind = which == 1 ? 2 : 3; e.ld = 0; e.rope_end = 0; e.k_beg = 0; e.k_end = 0; e.v_end = 0; e.kw = 0; e.outk = nullptr; e.outv = nullptr;
    WT = (const u16*)(p.ws + OFF_WTOUT + (size_t)layer * 2097152); ntn = 8;
  } else if (layer == 1) {
    e.kind = 0; e.ld = 4096; e.rope_end = 2048; e.k_beg = 1024; e.k_end = 2048; e.v_end = 3072; e.kw = 1024;
    e.outk = p.out + OUT_L1K; e.outv = p.out + OUT_L1V;
    WT = (const u16*)(p.ws + OFF_WTIN + WTIN_L1); ntn = 32;
  } else if (layer == 2) {
    e.kind = 1; e.ld = 4224; e.rope_end = 0; e.k_beg = 0; e.k_end = 0; e.v_end = 0; e.kw = 0; e.outk = nullptr; e.outv = nullptr;
    WT = (const u16*)(p.ws + OFF_WTIN + WTIN_L2); ntn = 32;
  } else {
    e.kind = 0; e.ld = 2560; e.rope_end = 1280; e.k_beg = 1024; e.k_end = 1280; e.v_end = 1536; e.kw = 256;
    e.outk = p.out + (layer == 0 ? OUT_L0K : OUT_L3K); e.outv = p.out + (layer == 0 ? OUT_L0V : OUT_L3V);
    WT = (const u16*)(p.ws + OFF_WTIN + (layer == 0 ? WTIN_L0 : WTIN_L3)); ntn = 20;
  }
  e.fused = (which == 0) ? (layer >= 1) : (which == 1 && layer < 3);
  const u16* A = (which == 0 && layer >= 1) ? (const u16*)(p.ws + OFF_HR) : H;
  gemm_phase(p, smem, A, WT, ntn, e);
}

constexpr int NPHASE = 30;
DI void run_phase(const Params& p, char* smem, int ph) {
  if (ph == 0) { phase0(p, smem); return; }
  if (ph == 29) { norm_phase(p, 4); return; }
  const int l = (ph - 1) / 7, s = (ph - 1) % 7;
  if (s == 0) norm_phase(p, l);
  else if (s == 1) gemm_for(p, smem, l, 0);
  else if (s == 6) gemm_for(p, smem, l, 1);
  else if (l == 2) {
    if (s == 2) dn_conv_phase(p);
    else if (s == 3) dn_chunk_phase(p, smem);
    else if (s == 4) dn_scan_phase(p, smem);
    else dn_out_phase(p);
  } else if (s == 2) {
    if (l == 1) attn_b_phase(p, smem); else attn_a_phase(p, smem, l);
  }
}
DI bool phase_empty(int ph) {
  if (ph == 0 || ph == 29) return false;
  const int l = (ph - 1) / 7, s = (ph - 1) % 7;
  return (l != 2) && (s >= 3 && s <= 5);
}

#if ONE_LAUNCH
__global__ void __launch_bounds__(256, 2) mega_kernel(Params p) {
  __shared__ __attribute__((aligned(16))) char smem[SMEM_BYTES];
  cg::grid_group grid = cg::this_grid();
  __shared__ uint4 xb_words;
  if (threadIdx.x == 0) xb_words = make_uint4(0u, 0u, 0u, 0u);
  __syncthreads();
  XcdBarrier xb = xcd_barrier_post((unsigned*)(p.ws + OFF_BAR), (volatile LAS unsigned*)&xb_words);
  if (p.ws == nullptr) grid.sync();
#define REP_0(x) x;
#define REP_1(x) x; x;
#define REP_I(n, x) REP_##n(x)
#define REP(n, x) REP_I(n, x)
#define GSYNC REP(DUP_SYNC, xcd_barrier(xb))
  REP(DUP_P0, phase0(p, smem)) GSYNC;
  REP(DUP_NORM, norm_phase(p, 0)) sw_tasks(p); GSYNC;
  REP(DUP_GEMM, gemm_for(p, smem, 0, 0)) GSYNC;
  REP(DUP_ATT, attn_a_phase(p, smem, 0)) GSYNC;
  gemm_for(p, smem, 0, 1);
#if DUP_OUT
  gemm_for(p, smem, 0, 2);
#endif
  GSYNC;
  REP(DUP_GEMM, gemm_for(p, smem, 1, 0)) GSYNC;
  REP(DUP_DN2, attn_b_phase(p, smem)) GSYNC;
  gemm_for(p, smem, 1, 1);
#if DUP_OUT
  gemm_for(p, smem, 1, 2);
#endif
  GSYNC;
  REP(DUP_GEMM, gemm_for(p, smem, 2, 0)) GSYNC;
  REP(DUP_DN, dn_conv_phase(p)) GSYNC;
  REP(DUP_DN, dn_chunk_phase(p, smem)) GSYNC;
  REP(DUP_DN, dn_scan_phase(p, smem)) GSYNC;
  REP(DUP_DN, dn_out_phase(p)) GSYNC;
  gemm_for(p, smem, 2, 1);
#if DUP_OUT
  gemm_for(p, smem, 2, 2);
#endif
  GSYNC;
  REP(DUP_GEMM, gemm_for(p, smem, 3, 0)) GSYNC;
  REP(DUP_ATT, attn_a_phase(p, smem, 3)) GSYNC;
  gemm_for(p, smem, 3, 1);
#if DUP_OUT
  gemm_for(p, smem, 3, 2);
#endif
  GSYNC;
  REP(DUP_NORM, norm_phase(p, 4))
}
#else
__global__ void __launch_bounds__(256, 2) phase_kernel(Params p, int ph) {
  __shared__ __attribute__((aligned(16))) char smem[SMEM_BYTES];
  run_phase(p, smem, ph);
}
#endif

extern "C" void kernel_launch(void* const* d_in, const int* in_sizes, int n_in, void* d_out, int out_size, void* d_ws, size_t ws_size,
                              hipStream_t stream) {
  if (n_in != 43 || ws_size < WS_END) { fprintf(stderr, "kernel_launch: unexpected n_in %d / ws_size %zu\n", n_in, ws_size); return; }
  Params p{};
  for (int i = 0; i < 43; ++i) p.in[i] = (const float*)d_in[i];
  p.out = (float*)d_out;
  p.ws = (char*)d_ws;
#if ONE_LAUNCH
  static int grid_blocks = 0;
  if (!grid_blocks) {
    int dev = 0, cus = 0, per_cu = 0;
    hipGetDevice(&dev);
    hipDeviceGetAttribute(&cus, hipDeviceAttributeMultiprocessorCount, dev);
    hipOccupancyMaxActiveBlocksPerMultiprocessor(&per_cu, mega_kernel, 256, 0);
    if (per_cu < 1) per_cu = 1;
    if (per_cu > 2) per_cu = 2;
    grid_blocks = cus * per_cu;
  }
  (void)hipMemsetAsync((char*)d_ws + OFF_BAR, 0, 16384, stream);
  void* args[] = {&p};
  hipError_t e = hipLaunchCooperativeKernel((void*)mega_kernel, dim3(grid_blocks), dim3(256), args, 0, stream);
  if (e != hipSuccess) fprintf(stderr, "cooperative launch failed: %s (grid %d)\n", hipGetErrorString(e), grid_blocks);
#else
  for (int ph = 0; ph < NPHASE; ++ph) { bool empty = (ph != 0 && ph != 29) && ((ph - 1) / 7 != 2) && ((ph - 1) % 7 >= 3 && (ph - 1) % 7 <= 5); if (!empty) phase_kernel<<<512, 256, 0, stream>>>(p, ph); }
#endif
}
```

```cpp
#include <hip/hip_runtime.h>
#include <hip/hip_bf16.h>
#include <hip/hip_cooperative_groups.h>
#include <cstdio>
namespace cg = cooperative_groups;

#define ONE_LAUNCH 1
#define DUP_P0 0
#define DUP_GEMM 0
#define DUP_ATT 0
#define DUP_DN 0
#define DUP_DN2 0
#define DUP_SYNC 0
#define DUP_NORM 0
#define DUP_OUT 0

typedef unsigned short u16;
using bf16x8 = __attribute__((ext_vector_type(8))) short;
using f32x4 = __attribute__((ext_vector_type(4))) float;
#define DI __device__ __forceinline__

constexpr size_t OFF_X    = 0;
constexpr size_t OFF_H    = OFF_X + 33554432;
constexpr size_t OFF_PR   = OFF_H + 16777216;
constexpr size_t OFF_WTIN = OFF_PR + 69206016;
constexpr size_t WTIN_L0 = 0, WTIN_L1 = 5242880, WTIN_L2 = WTIN_L1 + 8388608, WTIN_L3 = WTIN_L2 + 8650752;
constexpr size_t OFF_WTOUT = OFF_WTIN + 27525120;
constexpr size_t OFF_QN   = OFF_WTOUT + 8388608;
constexpr size_t OFF_KN   = OFF_QN + 16777216;
constexpr size_t OFF_VV   = OFF_KN + 16777216;
constexpr size_t OFF_TM   = OFF_VV + 16777216;
constexpr size_t OFF_OFB  = OFF_TM + 16777216;
constexpr size_t OFF_MOD  = OFF_OFB + 33554432;
constexpr size_t OFF_GATES= OFF_MOD + 245760;
constexpr size_t OFF_GB   = OFF_GATES + 1048576;
constexpr size_t OFF_ROPE = OFF_GB + 1048576;
constexpr size_t OFF_LAM  = OFF_ROPE + 8192;
constexpr size_t OFF_BAR  = OFF_LAM + 256;
constexpr size_t OFF_CK0  = OFF_BAR + 16384;
constexpr size_t OFF_CV0  = OFF_CK0 + 1048576;
constexpr size_t OFF_CK3  = OFF_CV0 + 1048576;
constexpr size_t OFF_CV3  = OFF_CK3 + 1048576;
constexpr size_t OFF_SS   = OFF_CV3 + 1048576;
constexpr size_t OFF_SW   = OFF_SS + 131072;
constexpr size_t WS_END   = OFF_SW + 337920;
constexpr size_t OFF_HR   = OFF_OFB + 8388608;
constexpr size_t OFF_CK1  = OFF_OFB;
constexpr size_t OFF_CV1  = OFF_OFB + 4194304;
constexpr size_t OFF_VT   = OFF_VV;

constexpr size_t OUT_Y = 0, OUT_L0K = 8388608, OUT_L0V = 9437184, OUT_L1K = 10485760, OUT_L1V = 14680064,
                 OUT_L2S = 18874368, OUT_L3K = 23068672, OUT_L3V = 24117248;

constexpr int SMEM_BYTES = 77824;
constexpr float NORM_EPS = 1e-6f;

struct Params {
  const float* in[43];
  float* out;
  char* ws;
};

__host__ __device__ constexpr int lbase(int l) { return l == 0 ? 11 : (l == 1 ? 17 : (l == 2 ? 27 : 36)); }

typedef __bf16 bf16x2_t __attribute__((ext_vector_type(2)));
typedef float f32x2_t __attribute__((ext_vector_type(2)));
DI u16 f2bf(float x) { __bf16 b = (__bf16)x; return __builtin_bit_cast(u16, b); }
DI float bf2f(u16 h) { return __uint_as_float(((unsigned)h) << 16); }
DI unsigned pack2(float a, float b) { f32x2_t v = {a, b}; bf16x2_t r = __builtin_convertvector(v, bf16x2_t); return __builtin_bit_cast(unsigned, r); }
DI float silu(float x) { return x / (1.f + __expf(-x)); }
DI float wave_sum(float v) { for (int o = 32; o; o >>= 1) v += __shfl_xor(v, o); return v; }
DI float grp16_sum(float v) { v += __shfl_xor(v, 1); v += __shfl_xor(v, 2); v += __shfl_xor(v, 4); v += __shfl_xor(v, 8); return v; }
DI float grp16_max(float v) { v = fmaxf(v, __shfl_xor(v, 1)); v = fmaxf(v, __shfl_xor(v, 2)); v = fmaxf(v, __shfl_xor(v, 4)); v = fmaxf(v, __shfl_xor(v, 8)); return v; }
DI f32x4 mfma(bf16x8 a, bf16x8 b, f32x4 c) { return __builtin_amdgcn_mfma_f32_16x16x32_bf16(a, b, c, 0, 0, 0); }
DI bf16x8 ldf(const u16* p) { return *reinterpret_cast<const bf16x8*>(p); }
DI f32x4 zero4() { f32x4 z = {0.f, 0.f, 0.f, 0.f}; return z; }
DI float4 ntload4(const float* p) { const f32x4 v = __builtin_nontemporal_load(reinterpret_cast<const f32x4*>(p)); return make_float4(v[0], v[1], v[2], v[3]); }
DI void ntstore4(float* p, float4 o) { f32x4 v = {o.x, o.y, o.z, o.w}; __builtin_nontemporal_store(v, reinterpret_cast<f32x4*>(p)); }

DI void phase0(const Params& p, char* smem) {
  const int tid = threadIdx.x;
  constexpr int NT_MOD = 384, NT_TR = 1680 + 512 + 384, NT_CK = 768;
  for (int task = blockIdx.x; task < NT_MOD + NT_TR + NT_CK + 1; task += gridDim.x) {
    __syncthreads();
    if (task < NT_MOD) {
      const int l = task / 96, cgp = task % 96;
      float* sc = (float*)smem;
      float* red = sc + 5 * 1024;
      for (int i = tid; i < 5 * 1024; i += 256) {
        int c = i >> 10, k = i & 1023;
        float v = (c == 0) ? p.in[10][k] : p.in[9][(c - 1) * 1024 + k];
        sc[i] = v / (1.f + expf(-v));
      }
      __syncthreads();
      const float* W = p.in[lbase(l) + 1];
      const float* mb = p.in[lbase(l) + 2];
      const int kg = tid >> 3, cp = tid & 7, n = cgp * 32 + cp * 4;
      float4 a[5];
#pragma unroll
      for (int c = 0; c < 5; ++c) a[c] = make_float4(0.f, 0.f, 0.f, 0.f);
      const float* wp = W + (size_t)(kg * 32) * 3072 + n;
#pragma unroll 16
      for (int k = 0; k < 32; ++k) {
        const float4 wv = ntload4(wp + (size_t)k * 3072);
#pragma unroll
        for (int c = 0; c < 5; ++c) { const float s = sc[c * 1024 + kg * 32 + k]; a[c].x += s * wv.x; a[c].y += s * wv.y; a[c].z += s * wv.z; a[c].w += s * wv.w; }
      }
#pragma unroll
      for (int c = 0; c < 5; ++c) *reinterpret_cast<float4*>(red + (kg * 5 + c) * 32 + cp * 4) = a[c];
      __syncthreads();
      float* MOD = (float*)(p.ws + OFF_MOD);
      if (tid < 160) {
        const int c = tid >> 5, col = tid & 31;
        float s = 0.f;
#pragma unroll
        for (int g = 0; g < 32; ++g) s += red[(g * 5 + c) * 32 + col];
        s += mb[cgp * 32 + col];
        MOD[(l * 5 + c) * 3072 + cgp * 32 + col] = s;
      }
    } else if (task < NT_MOD + NT_TR) {
      int tt = task - NT_MOD;
      const float* W; u16* WT; int N, sld, dld, kt, nt; bool vperm = false;
      if (tt < 1680) {
        int l, local, nn;
        if (tt < 320) { l = 0; local = tt; nn = 20; N = 2560; WT = (u16*)(p.ws + OFF_WTIN + WTIN_L0); }
        else if (tt < 832) { l = 1; local = tt - 320; nn = 32; N = 4096; WT = (u16*)(p.ws + OFF_WTIN + WTIN_L1); }
        else if (tt < 1360) { l = 2; local = tt - 832; nn = 33; N = 4128; WT = (u16*)(p.ws + OFF_WTIN + WTIN_L2); }
        else { l = 3; local = tt - 1360; nn = 20; N = 2560; WT = (u16*)(p.ws + OFF_WTIN + WTIN_L3); }
        W = p.in[lbase(l) + 3]; sld = N; dld = 1024;
        nt = (local % nn) * 2; kt = local / nn;
      } else if (tt < 2192) {
        int t2 = tt - 1680; int l = t2 >> 7; int local = t2 & 127;
        W = p.in[lbase(l) + 4]; WT = (u16*)(p.ws + OFF_WTOUT + (size_t)l * 2097152); N = 1024; sld = 1024; dld = 1024;
        nt = (local & 7) * 2; kt = local >> 3;
      } else {
        int t3 = tt - 2192, F, local; size_t doff;
        if (t3 < 64) { W = p.in[3]; F = 256; local = t3; doff = OFF_CV0; }
        else if (t3 < 128) { W = p.in[8]; F = 256; local = t3 - 64; doff = OFF_CV3; }
        else { W = p.in[5]; F = 1024; local = t3 - 128; doff = OFF_CV1; }
        const int per_b = 8 * (F / 128);
        const int b = local / per_b, r = local % per_b;
        kt = r & 7; nt = (r >> 3) * 2;
        W += (size_t)b * 512 * F; WT = (u16*)(p.ws + doff) + (size_t)b * F * 512; N = F; sld = F; dld = 512; vperm = true;
      }
      float* tl = (float*)smem;
      {
        const int kk0 = tid >> 4, nn = (tid & 15) * 4;
        float4 v4[2][4];
#pragma unroll
        for (int hh = 0; hh < 2; ++hh) {
          const int n = (nt + hh) * 64 + nn;
#pragma unroll
          for (int i = 0; i < 4; ++i)
            v4[hh][i] = (n < N) ? ntload4(W + (size_t)(kt * 64 + kk0 + 16 * i) * sld + n) : make_float4(0.f, 0.f, 0.f, 0.f);
        }
#pragma unroll
        for (int hh = 0; hh < 2; ++hh)
#pragma unroll
          for (int i = 0; i < 4; ++i) {
            float* d = tl + hh * 4160 + (kk0 + 16 * i) * 65 + nn;
            d[0] = v4[hh][i].x; d[1] = v4[hh][i].y; d[2] = v4[hh][i].z; d[3] = v4[hh][i].w;
          }
      }
      __syncthreads();
#pragma unroll
      for (int hh = 0; hh < 2; ++hh)
#pragma unroll
        for (int i = 0; i < 2; ++i) {
          const int nn = i * 32 + (tid >> 3), kc = tid & 7;
          const float* s = tl + hh * 4160 + (kc * 8) * 65 + nn;
          uint4 o;
          o.x = pack2(s[0], s[65]); o.y = pack2(s[130], s[195]); o.z = pack2(s[260], s[325]); o.w = pack2(s[390], s[455]);
          u16* dp = WT + (size_t)((nt + hh) * 64 + nn) * dld + kt * 64;
          if (vperm) {
            const int pb = (kc >> 2) * 32 + ((kc & 3) >> 1) * 4 + (kc & 1) * 16;
            uint2 lo2; lo2.x = o.x; lo2.y = o.y; uint2 hi2; hi2.x = o.z; hi2.y = o.w;
            *reinterpret_cast<uint2*>(dp + pb) = lo2;
            *reinterpret_cast<uint2*>(dp + pb + 8) = hi2;
          } else {
            *reinterpret_cast<uint4*>(dp + kc * 8) = o;
          }
        }
    } else if (task < NT_MOD + NT_TR + NT_CK) {
      int t4 = task - NT_MOD - NT_TR;
      const float* s; u16* d;
      if (t4 < 128) { s = p.in[2]; d = (u16*)(p.ws + OFF_CK0); }
      else if (t4 < 256) { s = p.in[7]; d = (u16*)(p.ws + OFF_CK3); t4 -= 128; }
      else { s = p.in[4]; d = (u16*)(p.ws + OFF_CK1); t4 -= 256; }
      const size_t base = (size_t)t4 * 4096 + tid * 16;
#pragma unroll
      for (int i = 0; i < 2; ++i) {
        const float4 a = ntload4(s + base + i * 8), b4 = ntload4(s + base + i * 8 + 4);
        uint4 o; o.x = pack2(a.x, a.y); o.y = pack2(a.z, a.w); o.z = pack2(b4.x, b4.y); o.w = pack2(b4.z, b4.w);
        *reinterpret_cast<uint4*>(d + base + i * 8) = o;
      }
    } else {
      float2* rope = (float2*)(p.ws + OFF_ROPE);
      for (int i = tid; i < 1024; i += 256) {
        int pos = i >> 4, f = i & 15;
        float inv = powf(10000.0f, -(float)f / 16.0f);
        float ang = (float)pos * inv;
        rope[i] = make_float2(cosf(ang), sinf(ang));
      }
      if (tid == 0) {
        float d1 = 0.f, d2 = 0.f;
        for (int i = 0; i < 64; ++i) { d1 += p.in[22][i] * p.in[23][i]; d2 += p.in[24][i] * p.in[25][i]; }
        float lam_init = 0.8f - 0.6f * expf(-0.3f);
        float* LAM = (float*)(p.ws + OFF_LAM);
        LAM[0] = expf(d1) - expf(d2) + lam_init;
        LAM[1] = lam_init;
        LAM[2] = 0.f;
      }
      {
        float4* ssz = (float4*)(p.ws + OFF_SS);
        for (int i = tid; i < 8192; i += 256) ssz[i] = make_float4(0.f, 0.f, 0.f, 0.f);
      }
    }
  }
}

DI void sw_tasks(const Params& p) {
  const int lane = threadIdx.x & 63, w = threadIdx.x >> 6;
  const float* MOD = (const float*)(p.ws + OFF_MOD);
  float* SW = (float*)(p.ws + OFF_SW);
  for (int task = blockIdx.x * 4 + w; task < 1348; task += gridDim.x * 4) {
    int l, t8; const u16* WT;
    if (task < 512) { l = 1; t8 = task; WT = (const u16*)(p.ws + OFF_WTIN + WTIN_L1); }
    else if (task < 1028) { l = 2; t8 = task - 512; WT = (const u16*)(p.ws + OFF_WTIN + WTIN_L2); }
    else { l = 3; t8 = task - 1028; WT = (const u16*)(p.ws + OFF_WTIN + WTIN_L3); }
    float sh[5][16];
#pragma unroll
    for (int c = 0; c < 5; ++c)
#pragma unroll
      for (int q4 = 0; q4 < 4; ++q4) {
        const float4 v = *reinterpret_cast<const float4*>(MOD + (size_t)(l * 5 + c) * 3072 + lane * 16 + q4 * 4);
        sh[c][q4 * 4] = v.x; sh[c][q4 * 4 + 1] = v.y; sh[c][q4 * 4 + 2] = v.z; sh[c][q4 * 4 + 3] = v.w;
      }
#pragma unroll 2
    for (int r = 0; r < 8; ++r) {
      const int n = t8 * 8 + r;
      const uint4 w0 = *reinterpret_cast<const uint4*>(WT + (size_t)n * 1024 + lane * 16);
      const uint4 w1 = *reinterpret_cast<const uint4*>(WT + (size_t)n * 1024 + lane * 16 + 8);
      float wf[16];
      wf[0] = bf2f((u16)(w0.x & 0xffff)); wf[1] = bf2f((u16)(w0.x >> 16)); wf[2] = bf2f((u16)(w0.y & 0xffff)); wf[3] = bf2f((u16)(w0.y >> 16));
      wf[4] = bf2f((u16)(w0.z & 0xffff)); wf[5] = bf2f((u16)(w0.z >> 16)); wf[6] = bf2f((u16)(w0.w & 0xffff)); wf[7] = bf2f((u16)(w0.w >> 16));
      wf[8] = bf2f((u16)(w1.x & 0xffff)); wf[9] = bf2f((u16)(w1.x >> 16)); wf[10] = bf2f((u16)(w1.y & 0xffff)); wf[11] = bf2f((u16)(w1.y >> 16));
      wf[12] = bf2f((u16)(w1.z & 0xffff)); wf[13] = bf2f((u16)(w1.z >> 16)); wf[14] = bf2f((u16)(w1.w & 0xffff)); wf[15] = bf2f((u16)(w1.w >> 16));
#pragma unroll
      for (int c = 0; c < 5; ++c) {
        float s = 0.f;
#pragma unroll
        for (int k = 0; k < 16; ++k) s += sh[c][k] * wf[k];
        s = wave_sum(s);
        if (lane == 0) SW[(size_t)(l * 5 + c) * 4224 + n] = s;
      }
    }
  }
}

DI void norm_phase(const Params& p, int layer) {
  const int lane = threadIdx.x & 63, w = threadIdx.x >> 6;
  float* X = (float*)(p.ws + OFF_X);
  u16* H = (u16*)(p.ws + OFF_H);
  const float* MOD = (const float*)(p.ws + OFF_MOD);
  const float* nw = (layer < 4) ? p.in[lbase(layer)] : p.in[42];
  for (int r = blockIdx.x * 4 + w; r < 8192; r += gridDim.x * 4) {
    const float* src = (layer == 0) ? (r < 4096 ? p.in[0] + (size_t)r * 1024 : p.in[1] + (size_t)(r - 4096) * 1024) : X + (size_t)r * 1024;
    float4 v[4];
    float ss = 0.f;
#pragma unroll
    for (int i = 0; i < 4; ++i) {
      v[i] = *reinterpret_cast<const float4*>(src + (i * 64 + lane) * 4);
      ss += v[i].x * v[i].x + v[i].y * v[i].y + v[i].z * v[i].z + v[i].w * v[i].w;
    }
    ss = wave_sum(ss);
    const float rs = rsqrtf(ss * (1.f / 1024.f) + NORM_EPS);
    if (layer < 4) {
      const int cond = r < 4096 ? 0 : 1 + ((r - 4096) >> 10);
      const float* md = MOD + (size_t)(layer * 5 + cond) * 3072;
#pragma unroll
      for (int i = 0; i < 4; ++i) {
        const int n = (i * 64 + lane) * 4;
        float4 g = *reinterpret_cast<const float4*>(nw + n);
        float4 sh = *reinterpret_cast<const float4*>(md + n);
        float4 sc = *reinterpret_cast<const float4*>(md + 1024 + n);
        float h0 = v[i].x * rs * g.x * (1.f + sc.x) + sh.x;
        float h1 = v[i].y * rs * g.y * (1.f + sc.y) + sh.y;
        float h2 = v[i].z * rs * g.z * (1.f + sc.z) + sh.z;
        float h3 = v[i].w * rs * g.w * (1.f + sc.w) + sh.w;
        uint2 pk; pk.x = pack2(h0, h1); pk.y = pack2(h2, h3);
        *reinterpret_cast<uint2*>(H + (size_t)r * 1024 + n) = pk;
      }
    } else {
#pragma unroll
      for (int i = 0; i < 4; ++i) {
        const int n = (i * 64 + lane) * 4;
        float4 g = *reinterpret_cast<const float4*>(nw + n);
        float4 o; o.x = v[i].x * rs * g.x; o.y = v[i].y * rs * g.y; o.z = v[i].z * rs * g.z; o.w = v[i].w * rs * g.w;
        ntstore4(p.out + OUT_Y + (size_t)r * 1024 + n, o);
      }
    }
  }
}

struct EpiArgs {
  int kind;
  int ld;
  int rope_end;
  int k_beg, k_end, v_end, kw;
  float* outk; float* outv;
  int layer;
  int fused;
};

DI void gemm_phase(const Params& p, char* smem, const u16* __restrict__ A, const u16* __restrict__ WT, int ntn, const EpiArgs e) {
  u16* As = (u16*)smem;
  u16* Bs = As + 2 * 128 * 64;
  const int tid = threadIdx.x, lane = tid & 63, w = tid >> 6, wm = w >> 1, wn = w & 1, l16 = lane & 15, quad = lane >> 4;
  const int ntiles = 64 * ntn;
  u16* PR = (u16*)(p.ws + OFF_PR);
  const int xg = blockIdx.x & 7, xl = blockIdx.x >> 3, xn = gridDim.x >> 3;
  (void)ntiles;
  for (int t = xl; t < 8 * ntn; t += xn) {
    const int tm = xg * 8 + (t & 7), tn = t >> 3;
    const int m0 = tm * 128, n0 = tn * 128;
    f32x4 acc[4][4];
#pragma unroll
    for (int i = 0; i < 4; ++i)
#pragma unroll
      for (int j = 0; j < 4; ++j) acc[i][j] = zero4();
    const u16* Ag = A + (size_t)m0 * 1024;
    const u16* Bg = WT + (size_t)n0 * 1024;
    const int lrow = tid >> 3, lkc = tid & 7;
    const char* Abase = (const char*)A;
    const char* Bbase = (const char*)WT;
    const unsigned aoff = (unsigned)((m0 + lrow) * 1024 + lkc * 8) * 2u;
    const unsigned boff = (unsigned)((n0 + lrow) * 1024 + lkc * 8) * 2u;
    u16* Ast = As + lrow * 64 + ((lkc ^ (lrow & 7)) * 8);
    u16* Bst = Bs + lrow * 64 + ((lkc ^ (lrow & 7)) * 8);
#define G_LD1(base_, off_) (*reinterpret_cast<const uint4*>((base_) + (off_)))
#define G_LOAD(S, kt_) \
    S##a0 = G_LD1(Abase, aoff + (unsigned)(kt_) * 128u); S##a1 = G_LD1(Abase, aoff + 65536u + (unsigned)(kt_) * 128u); \
    S##a2 = G_LD1(Abase, aoff + 131072u + (unsigned)(kt_) * 128u); S##a3 = G_LD1(Abase, aoff + 196608u + (unsigned)(kt_) * 128u); \
    S##b0 = G_LD1(Bbase, boff + (unsigned)(kt_) * 128u); S##b1 = G_LD1(Bbase, boff + 65536u + (unsigned)(kt_) * 128u); \
    S##b2 = G_LD1(Bbase, boff + 131072u + (unsigned)(kt_) * 128u); S##b3 = G_LD1(Bbase, boff + 196608u + (unsigned)(kt_) * 128u);
#define G_STORE(S, buf_) \
    *reinterpret_cast<uint4*>(Ast + (buf_) * 8192) = S##a0; *reinterpret_cast<uint4*>(Ast + (buf_) * 8192 + 32 * 64) = S##a1; \
    *reinterpret_cast<uint4*>(Ast + (buf_) * 8192 + 64 * 64) = S##a2; *reinterpret_cast<uint4*>(Ast + (buf_) * 8192 + 96 * 64) = S##a3; \
    *reinterpret_cast<uint4*>(Bst + (buf_) * 8192) = S##b0; *reinterpret_cast<uint4*>(Bst + (buf_) * 8192 + 32 * 64) = S##b1; \
    *reinterpret_cast<uint4*>(Bst + (buf_) * 8192 + 64 * 64) = S##b2; *reinterpret_cast<uint4*>(Bst + (buf_) * 8192 + 96 * 64) = S##b3;
#define G_COMPUTE(buf_) { \
      const u16* Ab = As + (buf_) * 8192 + (wm * 64 + l16) * 64; \
      const u16* Bb = Bs + (buf_) * 8192 + (wn * 64 + l16) * 64; \
      _Pragma("unroll") for (int ks = 0; ks < 2; ++ks) { \
        const int co = ((ks * 4 + quad) ^ (l16 & 7)) * 8; \
        bf16x8 af0 = ldf(Ab + co), af1 = ldf(Ab + 16 * 64 + co), af2 = ldf(Ab + 32 * 64 + co), af3 = ldf(Ab + 48 * 64 + co); \
        bf16x8 bf0 = ldf(Bb + co), bf1 = ldf(Bb + 16 * 64 + co), bf2 = ldf(Bb + 32 * 64 + co), bf3 = ldf(Bb + 48 * 64 + co); \
        acc[0][0] = mfma(bf0, af0, acc[0][0]); acc[0][1] = mfma(bf1, af0, acc[0][1]); acc[0][2] = mfma(bf2, af0, acc[0][2]); acc[0][3] = mfma(bf3, af0, acc[0][3]); \
        acc[1][0] = mfma(bf0, af1, acc[1][0]); acc[1][1] = mfma(bf1, af1, acc[1][1]); acc[1][2] = mfma(bf2, af1, acc[1][2]); acc[1][3] = mfma(bf3, af1, acc[1][3]); \
        acc[2][0] = mfma(bf0, af2, acc[2][0]); acc[2][1] = mfma(bf1, af2, acc[2][1]); acc[2][2] = mfma(bf2, af2, acc[2][2]); acc[2][3] = mfma(bf3, af2, acc[2][3]); \
        acc[3][0] = mfma(bf0, af3, acc[3][0]); acc[3][1] = mfma(bf1, af3, acc[3][1]); acc[3][2] = mfma(bf2, af3, acc[3][2]); acc[3][3] = mfma(bf3, af3, acc[3][3]); \
      } }
    uint4 Ra0, Ra1, Ra2, Ra3, Rb0, Rb1, Rb2, Rb3, Qa0, Qa1, Qa2, Qa3, Qb0, Qb1, Qb2, Qb3;
    G_LOAD(R, 0)
    G_LOAD(Q, 1)
    __syncthreads();
    G_STORE(R, 0)
    __syncthreads();
    for (int kt = 0; kt < 16; kt += 2) {
      const int k2 = kt + 2 < 16 ? kt + 2 : 14, k3 = kt + 3 < 16 ? kt + 3 : 15;
#define G_SCHED \
      __builtin_amdgcn_sched_group_barrier(0x100, 6, 0); \
      _Pragma("unroll") for (int sg_ = 0; sg_ < 2; ++sg_) { __builtin_amdgcn_sched_group_barrier(0x008, 1, 0); __builtin_amdgcn_sched_group_barrier(0x100, 1, 0); } \
      _Pragma("unroll") for (int sg_ = 0; sg_ < 8; ++sg_) { __builtin_amdgcn_sched_group_barrier(0x008, 2, 0); __builtin_amdgcn_sched_group_barrier(0x020, 1, 0); __builtin_amdgcn_sched_group_barrier(0x100, 1, 0); } \
      _Pragma("unroll") for (int sg_ = 0; sg_ < 7; ++sg_) { __builtin_amdgcn_sched_group_barrier(0x008, 2, 0); __builtin_amdgcn_sched_group_barrier(0x200, 1, 0); } \
      __builtin_amdgcn_sched_group_barrier(0x200, 1, 0);
      __builtin_amdgcn_sched_barrier(0);
      __builtin_amdgcn_s_setprio(1);
      G_LOAD(R, k2)
      G_COMPUTE(0)
      G_STORE(Q, 1)
      G_SCHED
      __builtin_amdgcn_sched_barrier(0);
      __builtin_amdgcn_s_setprio(0);
      __syncthreads();
      __builtin_amdgcn_s_setprio(1);
      G_LOAD(Q, k3)
      G_COMPUTE(1)
      G_STORE(R, 0)
      G_SCHED
      __builtin_amdgcn_sched_barrier(0);
      __builtin_amdgcn_s_setprio(0);
      __syncthreads();
#undef G_SCHED
    }
#undef G_LOAD
#undef G_LD1
#undef G_STORE
#undef G_COMPUTE
    const int nw = n0 + wn * 64;
    const int rbase = m0 + wm * 64 + l16;
    const int cq = quad * 4;
    if (e.kind <= 1 && e.fused) {
      const int cond = m0 < 4096 ? 0 : 1 + ((m0 - 4096) >> 10);
      const float* SS = (const float*)(p.ws + OFF_SS) + (size_t)e.layer * 8192;
      const float* SW = (const float*)(p.ws + OFF_SW) + (size_t)(e.layer * 5 + cond) * 4224 + nw + cq;
      float4 sw[4];
#pragma unroll
      for (int nb = 0; nb < 4; ++nb) sw[nb] = *reinterpret_cast<const float4*>(SW + nb * 16);
#pragma unroll
      for (int mb = 0; mb < 4; ++mb) {
        const float rs = rsqrtf(SS[rbase + mb * 16] * (1.f / 1024.f) + NORM_EPS);
#pragma unroll
        for (int nb = 0; nb < 4; ++nb) {
          acc[mb][nb][0] = rs * acc[mb][nb][0] + sw[nb].x; acc[mb][nb][1] = rs * acc[mb][nb][1] + sw[nb].y;
          acc[mb][nb][2] = rs * acc[mb][nb][2] + sw[nb].z; acc[mb][nb][3] = rs * acc[mb][nb][3] + sw[nb].w;
        }
      }
    }
    if (e.kind == 0) {
      const bool lat = m0 >= 4096;
      const bool do_rope = lat && nw < e.rope_end;
      const bool is_v = nw >= e.k_end && nw < e.v_end;
      const float2* rope = (const float2*)(p.ws + OFF_ROPE);
      if (!is_v) {
#pragma unroll
        for (int mb = 0; mb < 4; ++mb) {
          const int row = rbase + mb * 16;
          if (do_rope) {
            const int t = (row - 4096) & 1023;
            const float2* rr = rope + (t >> 6) * 16 + cq;
            const float2* rc = rope + (t & 63) * 16 + cq;
#pragma unroll
            for (int r = 0; r < 4; ++r) {
              const float2 cr = rr[r], cc = rc[r];
              const float v0 = acc[mb][0][r], v1 = acc[mb][1][r], v2 = acc[mb][2][r], v3 = acc[mb][3][r];
              acc[mb][0][r] = v0 * cr.x - v1 * cr.y; acc[mb][1][r] = v1 * cr.x + v0 * cr.y;
              acc[mb][2][r] = v2 * cc.x - v3 * cc.y; acc[mb][3][r] = v3 * cc.x + v2 * cc.y;
            }
          }
          u16* dst = PR + (size_t)row * e.ld + nw + cq;
#pragma unroll
          for (int nb = 0; nb < 4; ++nb) {
            uint2 pk; pk.x = pack2(acc[mb][nb][0], acc[mb][nb][1]); pk.y = pack2(acc[mb][nb][2], acc[mb][nb][3]);
            *reinterpret_cast<uint2*>(dst + nb * 16) = pk;
          }
        }
      } else {
        u16* Vst = (u16*)smem + w * (64 * 72);
#pragma unroll
        for (int mb = 0; mb < 4; ++mb)
#pragma unroll
          for (int nb = 0; nb < 4; ++nb)
#pragma unroll
            for (int r = 0; r < 4; ++r)
              Vst[(nb * 16 + cq + r) * 72 + (mb >> 1) * 32 + ((l16 >> 2) & 3) * 8 + (mb & 1) * 4 + (l16 & 3)] = f2bf(acc[mb][nb][r]);
        __builtin_amdgcn_fence(__ATOMIC_RELEASE, "wavefront");
        __builtin_amdgcn_s_waitcnt(0xc07f);
        __builtin_amdgcn_wave_barrier();
        u16* VT = (u16*)(p.ws + OFF_VT);
#pragma unroll
        for (int i = 0; i < 8; ++i) {
          const int c = lane + 64 * i, col = c >> 3, rc = c & 7;
          const uint4 v = *reinterpret_cast<const uint4*>(Vst + col * 72 + rc * 8);
          *reinterpret_cast<uint4*>(VT + (size_t)(nw - e.k_end + col) * 8192 + m0 + wm * 64 + rc * 8) = v;
        }
      }
      if (!lat && nw >= e.k_beg && nw < e.v_end) {
        float* ob = (nw < e.k_end) ? e.outk + (nw - e.k_beg) : e.outv + (nw - e.k_end);
#pragma unroll
        for (int mb = 0; mb < 4; ++mb) {
          float* o = ob + (size_t)(rbase + mb * 16) * e.kw + cq;
#pragma unroll
          for (int nb = 0; nb < 4; ++nb) {
            float4 v; v.x = acc[mb][nb][0]; v.y = acc[mb][nb][1]; v.z = acc[mb][nb][2]; v.w = acc[mb][nb][3];
            *reinterpret_cast<float4*>(o + nb * 16) = v;
          }
        }
      }
    } else if (e.kind == 1) {
      float* GATES = (float*)(p.ws + OFF_GATES);
#pragma unroll
      for (int mb = 0; mb < 4; ++mb) {
        const int row = rbase + mb * 16;
#pragma unroll
        for (int nb = 0; nb < 4; ++nb) {
          const int col = nw + nb * 16 + cq;
          if (col < 4096) {
            uint2 pk; pk.x = pack2(acc[mb][nb][0], acc[mb][nb][1]); pk.y = pack2(acc[mb][nb][2], acc[mb][nb][3]);
            *reinterpret_cast<uint2*>(PR + (size_t)row * 4224 + col) = pk;
          } else if (col < 4128) {
            float4 v; v.x = acc[mb][nb][0]; v.y = acc[mb][nb][1]; v.z = acc[mb][nb][2]; v.w = acc[mb][nb][3];
            *reinterpret_cast<float4*>(GATES + (size_t)row * 32 + (col - 4096)) = v;
          }
        }
      }
    } else {
      float* X = (float*)(p.ws + OFF_X);
      const float* MOD = (const float*)(p.ws + OFF_MOD);
      const int cond = m0 < 4096 ? 0 : 1 + ((m0 - 4096) >> 10);
      const float* gate = MOD + (size_t)(e.layer * 5 + cond) * 3072 + 2048;
      const float gsc = (e.kind == 3) ? ((const float*)(p.ws + OFF_LAM))[2] : 1.f;
      const float* nwn = p.in[lbase(e.layer < 3 ? e.layer + 1 : 3)];
      const float* scn = MOD + (size_t)((e.layer < 3 ? e.layer + 1 : 3) * 5 + cond) * 3072 + 1024;
      u16* HR = (u16*)(p.ws + OFF_HR);
      float ssp[4] = {0.f, 0.f, 0.f, 0.f};
#pragma unroll
      for (int nb = 0; nb < 4; ++nb) {
        const int col = nw + nb * 16 + cq;
        float4 g = *reinterpret_cast<const float4*>(gate + col);
        g.x *= gsc; g.y *= gsc; g.z *= gsc; g.w *= gsc;
        float4 gm = make_float4(0.f, 0.f, 0.f, 0.f);
        if (e.fused) {
          const float4 a = *reinterpret_cast<const float4*>(nwn + col), b = *reinterpret_cast<const float4*>(scn + col);
          gm.x = a.x * (1.f + b.x); gm.y = a.y * (1.f + b.y); gm.z = a.z * (1.f + b.z); gm.w = a.w * (1.f + b.w);
        }
#pragma unroll
        for (int mb = 0; mb < 4; ++mb) {
          const int xrow = rbase + mb * 16;
          float* xp = X + (size_t)xrow * 1024 + col;
          const float* xs = (e.layer == 0) ? (xrow < 4096 ? p.in[0] + (size_t)xrow * 1024 + col : p.in[1] + (size_t)(xrow - 4096) * 1024 + col) : xp;
          float4 x = *reinterpret_cast<const float4*>(xs);
          x.x += g.x * acc[mb][nb][0]; x.y += g.y * acc[mb][nb][1]; x.z += g.z * acc[mb][nb][2]; x.w += g.w * acc[mb][nb][3];
          *reinterpret_cast<float4*>(xp) = x;
          if (e.fused) {
            ssp[mb] += x.x * x.x + x.y * x.y + x.z * x.z + x.w * x.w;
            uint2 pk; pk.x = pack2(x.x * gm.x, x.y * gm.y); pk.y = pack2(x.z * gm.z, x.w * gm.w);
            *reinterpret_cast<uint2*>(HR + (size_t)(rbase + mb * 16) * 1024 + col) = pk;
          }
        }
      }
      if (e.fused) {
        float* SSn = (float*)(p.ws + OFF_SS) + (size_t)(e.layer + 1) * 8192;
#pragma unroll
        for (int mb = 0; mb < 4; ++mb) {
          float s = ssp[mb];
          s += __shfl_xor(s, 16); s += __shfl_xor(s, 32);
          if (quad == 0) atomicAdd(SSn + rbase + mb * 16, s);
        }
      }
    }
  }
}

struct AttnItem {
  const u16* kb; int ldk;
  const u16* vtb;
  const u16* kc; int ldkc;
  const u16* vtc;
  int t_lo, n_loc, n_cache, mask;
};

template <int KW, int NDV>
DI void attn_core(char* smem, const AttnItem& it, const bf16x8 (&qf)[2][2], int koff, int qi0,
                  f32x4 (&O)[NDV][2], float (&mrun)[2], float (&lrun)[2]) {
  constexpr int KLD = KW + 16;
  constexpr int NKC = KW / 32;
  constexpr int NVC = NDV / 2;
  u16* Ks = (u16*)smem;
  u16* Vt = Ks + 64 * KLD;
  const int tid = threadIdx.x, lane = tid & 63, l16 = lane & 15, quad = lane >> 4;
  const int ntile = it.n_loc + it.n_cache;
  const int krow = tid / (KW / 8), kdc = tid % (KW / 8);
  const int vrow = tid >> 3, vdc = tid & 7;
  constexpr int KRS = 2048 / KW;
  uint4 pk0, pk1, pk2, pk3, pv0, pv1, pv2, pv3;
  uint4 qk0, qk1, qk2, qk3, qv0, qv1, qv2, qv3;
  pk2 = pk3 = pv2 = pv3 = make_uint4(0u, 0u, 0u, 0u);
  qk0 = qk1 = qk2 = qk3 = qv0 = qv1 = qv2 = qv3 = make_uint4(0u, 0u, 0u, 0u);
  constexpr bool DIST2 = (NKC == 2);
  int ld_ = it.ldk, vld_ = 8192;
  const u16* kp_ = it.kb + (size_t)(it.t_lo * 64 + krow) * it.ldk + kdc * 8;
  const u16* vp_ = it.vtb + (size_t)vrow * 8192 + it.t_lo * 64 + vdc * 8;
#define A_GLOAD(S, t_) do { \
    if ((t_) == it.n_loc) { ld_ = it.ldkc; vld_ = 512; kp_ = it.kc + (size_t)krow * it.ldkc + kdc * 8; vp_ = it.vtc + (size_t)vrow * 512 + vdc * 8; } \
    S##k0 = *reinterpret_cast<const uint4*>(kp_); S##k1 = *reinterpret_cast<const uint4*>(kp_ + (size_t)KRS * ld_); \
    if (NKC > 2) { S##k2 = *reinterpret_cast<const uint4*>(kp_ + (size_t)2 * KRS * ld_); S##k3 = *reinterpret_cast<const uint4*>(kp_ + (size_t)3 * KRS * ld_); } \
    S##v0 = *reinterpret_cast<const uint4*>(vp_); S##v1 = *reinterpret_cast<const uint4*>(vp_ + (size_t)32 * vld_); \
    if (NVC > 2) { S##v2 = *reinterpret_cast<const uint4*>(vp_ + (size_t)64 * vld_); S##v3 = *reinterpret_cast<const uint4*>(vp_ + (size_t)96 * vld_); } \
    kp_ += (size_t)64 * ld_; vp_ += 64; \
  } while (0)
#define A_LSTORE(S, buf_) do { \
      u16* kd = Ks + (buf_) * BUFE + krow * KLD + kdc * 8; \
      *reinterpret_cast<uint4*>(kd) = S##k0; *reinterpret_cast<uint4*>(kd + KRS * KLD) = S##k1; \
      if (NKC > 2) { *reinterpret_cast<uint4*>(kd + 2 * KRS * KLD) = S##k2; *reinterpret_cast<uint4*>(kd + 3 * KRS * KLD) = S##k3; } \
      u16* vd = Vt + (buf_) * BUFE + vrow * 80 + vdc * 8; \
      *reinterpret_cast<uint4*>(vd) = S##v0; *reinterpret_cast<uint4*>(vd + 32 * 80) = S##v1; \
      if (NVC > 2) { *reinterpret_cast<uint4*>(vd + 64 * 80) = S##v2; *reinterpret_cast<uint4*>(vd + 96 * 80) = S##v3; } \
    } while (0)
  constexpr int BUFE = 64 * KLD + NDV * 16 * 80;
  constexpr float SC = 0.125f * 1.4426950408889634f;
  constexpr bool PAIR = DIST2;
  constexpr int NKB = PAIR ? 8 : 4;
  const int niter = PAIR ? (ntile + 1) / 2 : ntile;
  A_GLOAD(p, 0);
  if (PAIR) { if (ntile > 1) A_GLOAD(q, 1); }
  __syncthreads();
  A_LSTORE(p, 0);
  if (PAIR) { if (ntile > 1) A_LSTORE(q, 1); }
  __syncthreads();
  if (PAIR) { if (ntile > 2) A_GLOAD(p, 2); if (ntile > 3) A_GLOAD(q, 3); } else { if (ntile > 1) A_GLOAD(p, 1); }
  for (int itn = 0; itn < niter; ++itn) {
    const int t = PAIR ? 2 * itn : itn;
    const bool two = PAIR && (t + 1 < ntile);
    const u16* Kb0 = Ks + (PAIR ? 0 : (t & 1)) * BUFE;
    const u16* Vb0 = Vt + (PAIR ? 0 : (t & 1)) * BUFE;
    const u16* Kb1 = Ks + BUFE;
    const u16* Vb1 = Vt + BUFE;
    f32x4 S[2][NKB];
#pragma unroll
    for (int nq = 0; nq < 2; ++nq)
#pragma unroll
      for (int kb = 0; kb < NKB; ++kb) S[nq][kb] = zero4();
    __builtin_amdgcn_s_setprio(1);
#pragma unroll
    for (int kb = 0; kb < 4; ++kb)
#pragma unroll
      for (int ks = 0; ks < 2; ++ks) {
        const bf16x8 kf = ldf(Kb0 + (kb * 16 + l16) * KLD + koff + ks * 32 + quad * 8);
        S[0][kb] = mfma(kf, qf[0][ks], S[0][kb]);
        S[1][kb] = mfma(kf, qf[1][ks], S[1][kb]);
      }
    if (PAIR) {
      if (two) {
#pragma unroll
        for (int kb = 0; kb < 4; ++kb)
#pragma unroll
          for (int ks = 0; ks < 2; ++ks) {
            const bf16x8 kf = ldf(Kb1 + (kb * 16 + l16) * KLD + koff + ks * 32 + quad * 8);
            S[0][NKB - 4 + kb] = mfma(kf, qf[0][ks], S[0][NKB - 4 + kb]);
            S[1][NKB - 4 + kb] = mfma(kf, qf[1][ks], S[1][NKB - 4 + kb]);
          }
      } else {
#pragma unroll
        for (int kb = 0; kb < 4; ++kb) {
          f32x4 neg = {-1e30f, -1e30f, -1e30f, -1e30f};
          S[0][NKB - 4 + kb] = neg; S[1][NKB - 4 + kb] = neg;
        }
      }
    }
    __builtin_amdgcn_s_setprio(0);
    const bool mask0 = it.mask && (t < it.n_loc);
    const bool mask1 = PAIR && it.mask && (t + 1 < it.n_loc);
    const int key00 = (it.t_lo + t) * 64;
    bf16x8 P[2][NKB / 2];
#pragma unroll
    for (int nq = 0; nq < 2; ++nq) {
      float mx = -1e30f;
      const int qi = qi0 + nq * 16 + l16;
#pragma unroll
      for (int kb = 0; kb < NKB; ++kb)
#pragma unroll
        for (int j = 0; j < 4; ++j) {
          float v = S[nq][kb][j];
          if (kb < 4 ? mask0 : mask1) {
            const int d = (key00 + kb * 16 + quad * 4 + j) - qi;
            if (d > 128 || d < -128) v = -1e30f;
            S[nq][kb][j] = v;
          }
          mx = fmaxf(mx, v);
        }
      mx = fmaxf(mx, __shfl_xor(mx, 16));
      mx = fmaxf(mx, __shfl_xor(mx, 32));
      const float mnew = fmaxf(mrun[nq], mx);
      const float alpha = __builtin_amdgcn_exp2f((mrun[nq] - mnew) * SC);
      const float mb = -mnew * SC;
      mrun[nq] = mnew;
      float ls = 0.f;
#pragma unroll
      for (int kb = 0; kb < NKB; ++kb)
#pragma unroll
        for (int j = 0; j < 4; ++j) { const float pe = __builtin_amdgcn_exp2f(fmaf(S[nq][kb][j], SC, mb)); S[nq][kb][j] = pe; ls += pe; }
      lrun[nq] = lrun[nq] * alpha + ls;
#pragma unroll
      for (int dvb = 0; dvb < NDV; ++dvb) { O[dvb][nq][0] *= alpha; O[dvb][nq][1] *= alpha; O[dvb][nq][2] *= alpha; O[dvb][nq][3] *= alpha; }
#pragma unroll
      for (int ks = 0; ks < NKB / 2; ++ks) {
        uint4 u;
        u.x = pack2(S[nq][2 * ks][0], S[nq][2 * ks][1]); u.y = pack2(S[nq][2 * ks][2], S[nq][2 * ks][3]);
        u.z = pack2(S[nq][2 * ks + 1][0], S[nq][2 * ks + 1][1]); u.w = pack2(S[nq][2 * ks + 1][2], S[nq][2 * ks + 1][3]);
        P[nq][ks] = __builtin_bit_cast(bf16x8, u);
      }
    }
    if (!PAIR) {
      if (t + 1 < ntile) {
        A_LSTORE(p, (t + 1) & 1);
        if (t + 2 < ntile) A_GLOAD(p, t + 2);
      }
    }
    __builtin_amdgcn_s_setprio(1);
#pragma unroll
    for (int dvb = 0; dvb < NDV; ++dvb)
#pragma unroll
      for (int ks = 0; ks < 2; ++ks) {
        const bf16x8 vf = ldf(Vb0 + (dvb * 16 + l16) * 80 + ks * 32 + quad * 8);
        O[dvb][0] = mfma(vf, P[0][ks], O[dvb][0]);
        O[dvb][1] = mfma(vf, P[1][ks], O[dvb][1]);
      }
    if (PAIR) {
      if (two) {
#pragma unroll
        for (int dvb = 0; dvb < NDV; ++dvb)
#pragma unroll
          for (int ks = 0; ks < 2; ++ks) {
            const bf16x8 vf = ldf(Vb1 + (dvb * 16 + l16) * 80 + ks * 32 + quad * 8);
            O[dvb][0] = mfma(vf, P[0][NKB / 2 - 2 + ks], O[dvb][0]);
            O[dvb][1] = mfma(vf, P[1][NKB / 2 - 2 + ks], O[dvb][1]);
          }
      }
      __builtin_amdgcn_s_setprio(0);
      if (itn + 1 < niter) {
        __syncthreads();
        A_LSTORE(p, 0);
        if (t + 3 < ntile) A_LSTORE(q, 1);
        __syncthreads();
        if (t + 4 < ntile) A_GLOAD(p, t + 4);
        if (t + 5 < ntile) A_GLOAD(q, t + 5);
      }
    } else {
      __builtin_amdgcn_s_setprio(0);
      if (t + 1 < ntile) __syncthreads();
    }
  }
}
#undef A_LSTORE
#undef A_GLOAD
DI void attn_a_phase(const Params& p, char* smem, int layer) {
  const int tid = threadIdx.x, lane = tid & 63, w = tid >> 6, l16 = lane & 15, quad = lane >> 4;
  const u16* PR = (const u16*)(p.ws + OFF_PR);
  const u16* VT = (const u16*)(p.ws + OFF_VT);
  u16* OG = (u16*)(p.ws + OFF_H);
  const float* sink = p.in[lbase(layer) + 5];
  const u16* CK = (const u16*)(p.ws + (layer == 0 ? OFF_CK0 : OFF_CK3));
  const u16* CV = (const u16*)(p.ws + (layer == 0 ? OFF_CV0 : OFF_CV3));
  for (int itx0 = blockIdx.x; itx0 < 1024; itx0 += gridDim.x) {
    const bool lat = itx0 < 512;
    const int v0 = lat ? itx0 : itx0 - 512;
    const int itx = (v0 & 7) * 64 + (v0 >> 3);
    int qt, hkv, b, seq_row;
    AttnItem it;
    if (lat) {
      qt = itx & 31; hkv = (itx >> 5) & 3; b = itx >> 7; seq_row = 4096 + b * 1024;
      const int q0 = qt * 32;
      it.t_lo = (q0 >= 128 ? q0 - 128 : 0) >> 6;
      int t_hi = (q0 + 159) >> 6; if (t_hi > 15) t_hi = 15;
      it.n_loc = t_hi - it.t_lo + 1; it.mask = 1; it.n_cache = 8;
      it.kc = CK + (size_t)b * 512 * 256 + hkv * 64; it.ldkc = 256;
      it.vtc = CV + (size_t)(b * 256 + hkv * 64) * 512;
    } else {
      const int id = itx;
      qt = id & 7; hkv = (id >> 3) & 3; b = id >> 5; seq_row = b * 256;
      it.t_lo = 0; it.n_loc = 4; it.mask = 0; it.n_cache = 0; it.kc = nullptr; it.ldkc = 0; it.vtc = nullptr;
    }
    it.kb = PR + (size_t)seq_row * 2560 + 1024 + hkv * 64; it.ldk = 2560;
    it.vtb = VT + (size_t)(hkv * 64) * 8192 + seq_row;
    const int hq = hkv * 4 + w;
    bf16x8 qf[2][2];
#pragma unroll
    for (int nq = 0; nq < 2; ++nq) {
      const u16* qp = PR + (size_t)(seq_row + qt * 32 + nq * 16 + l16) * 2560 + hq * 64 + quad * 8;
      qf[nq][0] = ldf(qp); qf[nq][1] = ldf(qp + 32);
    }
    f32x4 O[4][2];
    float mrun[2], lrun[2];
    const float sk = sink[hq];
#pragma unroll
    for (int nq = 0; nq < 2; ++nq) { mrun[nq] = sk * 8.f; lrun[nq] = (quad == 0) ? 1.f : 0.f; }
#pragma unroll
    for (int d = 0; d < 4; ++d) { O[d][0] = zero4(); O[d][1] = zero4(); }
    attn_core<64, 4>(smem, it, qf, 0, qt * 32, O, mrun, lrun);
#pragma unroll
    for (int nq = 0; nq < 2; ++nq) {
      float l = lrun[nq]; l += __shfl_xor(l, 16); l += __shfl_xor(l, 32);
      const float inv = 1.f / l;
      const int row = seq_row + qt * 32 + nq * 16 + l16;
#pragma unroll
      for (int dvb = 0; dvb < 4; ++dvb) {
        const int col = hq * 64 + dvb * 16 + quad * 4;
        const uint2 zz = *reinterpret_cast<const uint2*>(PR + (size_t)row * 2560 + 1536 + col);
        const float z0 = bf2f((u16)(zz.x & 0xffff)), z1 = bf2f((u16)(zz.x >> 16)), z2 = bf2f((u16)(zz.y & 0xffff)), z3 = bf2f((u16)(zz.y >> 16));
        uint2 o;
        o.x = pack2(O[dvb][nq][0] * inv * silu(z0), O[dvb][nq][1] * inv * silu(z1));
        o.y = pack2(O[dvb][nq][2] * inv * silu(z2), O[dvb][nq][3] * inv * silu(z3));
        *reinterpret_cast<uint2*>(OG + (size_t)row * 1024 + col) = o;
      }
    }
  }
}

DI void attn_b_phase(const Params& p, char* smem) {
  const int tid = threadIdx.x, lane = tid & 63, w = tid >> 6, l16 = lane & 15, quad = lane >> 4;
  const int comp = w & 1, qh = w >> 1;
  const u16* PR = (const u16*)(p.ws + OFF_PR);
  const u16* VT = (const u16*)(p.ws + OFF_VT);
  u16* OG = (u16*)(p.ws + OFF_H);
  const float* LAM = (const float*)(p.ws + OFF_LAM);
  const float lam = LAM[0], lam_init = LAM[1];
  const float* subw = p.in[26];
  const u16* CK = (const u16*)(p.ws + OFF_CK1);
  const u16* CV = (const u16*)(p.ws + OFF_CV1);
  float4* Ox = (float4*)smem;
  for (int itx0 = blockIdx.x; itx0 < 1024; itx0 += gridDim.x) {
    const bool lat = itx0 < 512;
    const int v0 = lat ? itx0 : itx0 - 512;
    const int itx = (v0 & 7) * 64 + (v0 >> 3);
    int qt, h, b, seq_row;
    AttnItem it;
    if (lat) {
      qt = itx & 15; h = (itx >> 4) & 7; b = itx >> 7; seq_row = 4096 + b * 1024; it.n_loc = 16; it.n_cache = 8;
      it.kc = CK + (size_t)b * 512 * 1024 + h * 128; it.ldkc = 1024;
      it.vtc = CV + (size_t)(b * 1024 + h * 128) * 512;
    } else {
      const int id = itx; qt = id & 3; h = (id >> 2) & 7; b = id >> 5; seq_row = b * 256; it.n_loc = 4; it.n_cache = 0;
      it.kc = nullptr; it.ldkc = 0; it.vtc = nullptr;
    }
    it.t_lo = 0; it.mask = 0;
    it.kb = PR + (size_t)seq_row * 4096 + 1024 + h * 128; it.ldk = 4096;
    it.vtb = VT + (size_t)(h * 128) * 8192 + seq_row;
    bf16x8 qf[2][2];
#pragma unroll
    for (int nq = 0; nq < 2; ++nq) {
      const u16* qp = PR + (size_t)(seq_row + qt * 64 + qh * 32 + nq * 16 + l16) * 4096 + h * 128 + comp * 64 + quad * 8;
      qf[nq][0] = ldf(qp); qf[nq][1] = ldf(qp + 32);
    }
    f32x4 O[8][2];
    float mrun[2], lrun[2];
#pragma unroll
    for (int nq = 0; nq < 2; ++nq) { mrun[nq] = -1e30f; lrun[nq] = 0.f; }
#pragma unroll
    for (int d = 0; d < 8; ++d) { O[d][0] = zero4(); O[d][1] = zero4(); }
    attn_core<128, 8>(smem, it, qf, comp * 64, qt * 64 + qh * 32, O, mrun, lrun);
    float inv[2];
#pragma unroll
    for (int nq = 0; nq < 2; ++nq) { float l = lrun[nq]; l += __shfl_xor(l, 16); l += __shfl_xor(l, 32); inv[nq] = 1.f / l; }
    __syncthreads();
    if (comp == 1) {
#pragma unroll
      for (int d = 0; d < 8; ++d)
#pragma unroll
        for (int nq = 0; nq < 2; ++nq) {
          float4 v; v.x = O[d][nq][0] * inv[nq]; v.y = O[d][nq][1] * inv[nq]; v.z = O[d][nq][2] * inv[nq]; v.w = O[d][nq][3] * inv[nq];
          Ox[((qh * 8 + d) * 2 + nq) * 64 + lane] = v;
        }
    }
    __syncthreads();
    if (comp == 0) {
#pragma unroll
      for (int nq = 0; nq < 2; ++nq) {
        float ss = 0.f;
#pragma unroll
        for (int d = 0; d < 8; ++d) {
          const float4 o1 = Ox[((qh * 8 + d) * 2 + nq) * 64 + lane];
          const float d0 = O[d][nq][0] * inv[nq] - lam * o1.x, d1 = O[d][nq][1] * inv[nq] - lam * o1.y;
          const float d2 = O[d][nq][2] * inv[nq] - lam * o1.z, d3 = O[d][nq][3] * inv[nq] - lam * o1.w;
          O[d][nq][0] = d0; O[d][nq][1] = d1; O[d][nq][2] = d2; O[d][nq][3] = d3;
          ss += d0 * d0 + d1 * d1 + d2 * d2 + d3 * d3;
        }
        ss += __shfl_xor(ss, 16); ss += __shfl_xor(ss, 32);
        const float rs = rsqrtf(ss * (1.f / 128.f) + NORM_EPS) * (1.f - lam_init);
        const int row = seq_row + qt * 64 + qh * 32 + nq * 16 + l16;
#pragma unroll
        for (int d = 0; d < 8; ++d) {
          const int e0 = d * 16 + quad * 4;
          const int col = h * 128 + e0;
          const uint2 zz = *reinterpret_cast<const uint2*>(PR + (size_t)row * 4096 + 3072 + col);
          const float z0 = bf2f((u16)(zz.x & 0xffff)), z1 = bf2f((u16)(zz.x >> 16)), z2 = bf2f((u16)(zz.y & 0xffff)), z3 = bf2f((u16)(zz.y >> 16));
          const float4 sw = *reinterpret_cast<const float4*>(subw + e0);
          uint2 o;
          o.x = pack2(O[d][nq][0] * rs * sw.x * silu(z0), O[d][nq][1] * rs * sw.y * silu(z1));
          o.y = pack2(O[d][nq][2] * rs * sw.z * silu(z2), O[d][nq][3] * rs * sw.w * silu(z3));
          *reinterpret_cast<uint2*>(OG + (size_t)row * 1024 + col) = o;
        }
      }
    }
  }
}

DI void unpack8(const uint4 v, float (&f)[8]) {
  f[0] = bf2f((u16)(v.x & 0xffff)); f[1] = bf2f((u16)(v.x >> 16)); f[2] = bf2f((u16)(v.y & 0xffff)); f[3] = bf2f((u16)(v.y >> 16));
  f[4] = bf2f((u16)(v.z & 0xffff)); f[5] = bf2f((u16)(v.z >> 16)); f[6] = bf2f((u16)(v.w & 0xffff)); f[7] = bf2f((u16)(v.w >> 16));
}
DI void dn_conv_phase(const Params& p) {
  const int lane = threadIdx.x & 63, w = threadIdx.x >> 6, l16 = lane & 15, gsub = lane >> 4;
  const u16* PR = (const u16*)(p.ws + OFF_PR);
  const float* cw = p.in[32];
  const float* GATES = (const float*)(p.ws + OFF_GATES);
  float* GB = (float*)(p.ws + OFF_GB);
  constexpr int NCONV = 1024 * 6, NGATE = 512;
  for (int task = blockIdx.x * 4 + w; task < NCONV + NGATE; task += gridDim.x * 4) {
    if (task >= NCONV) {
      const int row0 = (task - NCONV) * 16;
      const u16* HR = (const u16*)(p.ws + OFF_HR);
      const u16* WG = (const u16*)(p.ws + OFF_WTIN + WTIN_L2) + (size_t)4096 * 1024;
      const int quad = lane >> 4;
      const u16* ap = HR + (size_t)(row0 + l16) * 1024 + quad * 8;
      const u16* bp0 = WG + (size_t)l16 * 1024 + quad * 8;
      const u16* bp1 = WG + (size_t)(16 + l16) * 1024 + quad * 8;
      f32x4 g0 = zero4(), g1 = zero4();
#pragma unroll 8
      for (int ks = 0; ks < 32; ++ks) {
        const bf16x8 a = ldf(ap + ks * 32), b0 = ldf(bp0 + ks * 32), b1 = ldf(bp1 + ks * 32);
        g0 = mfma(a, b0, g0);
        g1 = mfma(a, b1, g1);
      }
      const int cond = row0 < 4096 ? 0 : 1 + ((row0 - 4096) >> 10);
      const float* SS = (const float*)(p.ws + OFF_SS) + 2 * 8192;
      const float* SWg = (const float*)(p.ws + OFF_SW) + (size_t)(2 * 5 + cond) * 4224 + 4096;
      const float sw0 = SWg[l16], sw1 = SWg[16 + l16];
      const float dtb = p.in[34][l16], ea = expf(p.in[33][l16]);
#pragma unroll
      for (int r = 0; r < 4; ++r) {
        const int row = row0 + quad * 4 + r;
        const float rs = rsqrtf(SS[row] * (1.f / 1024.f) + NORM_EPS);
        const float raw_b = rs * g0[r] + sw0, raw_a = rs * g1[r] + sw1;
        GB[(size_t)row * 32 + l16] = 1.f / (1.f + expf(-raw_b));
        const float x = raw_a + dtb;
        const float sp = fmaxf(x, 0.f) + log1pf(expf(-fabsf(x)));
        GB[(size_t)row * 32 + 16 + l16] = -ea * sp;
      }
      continue;
    }
    const int strip = task / 6, g4 = task - strip * 6;
    const int g = g4 * 4 + gsub;
    const int r0 = strip * 8;
    int t0, L;
    if (r0 < 4096) { t0 = r0 & 255; L = 256; } else { t0 = (r0 - 4096) & 1023; L = 1024; }
    const int ch = g * 128 + l16 * 8;
    const u16* src = PR + (size_t)r0 * 4224 + ch;
    uint4 rows[10];
    const uint4 z4 = make_uint4(0u, 0u, 0u, 0u);
    rows[0] = (t0 > 0) ? *reinterpret_cast<const uint4*>(src - 4224) : z4;
#pragma unroll
    for (int i = 0; i < 8; ++i) rows[i + 1] = *reinterpret_cast<const uint4*>(src + (size_t)i * 4224);
    rows[9] = (t0 + 8 < L) ? *reinterpret_cast<const uint4*>(src + (size_t)8 * 4224) : z4;
    float w0[8], w1[8], w2[8];
#pragma unroll
    for (int k = 0; k < 2; ++k) {
      const float4 a = *reinterpret_cast<const float4*>(cw + ch + k * 4), b = *reinterpret_cast<const float4*>(cw + 3072 + ch + k * 4), c = *reinterpret_cast<const float4*>(cw + 6144 + ch + k * 4);
      w0[k * 4] = a.x; w0[k * 4 + 1] = a.y; w0[k * 4 + 2] = a.z; w0[k * 4 + 3] = a.w;
      w1[k * 4] = b.x; w1[k * 4 + 1] = b.y; w1[k * 4 + 2] = b.z; w1[k * 4 + 3] = b.w;
      w2[k * 4] = c.x; w2[k * 4 + 1] = c.y; w2[k * 4 + 2] = c.z; w2[k * 4 + 3] = c.w;
    }
    u16* dstb = (u16*)(p.ws + (g < 8 ? OFF_QN : (g < 16 ? OFF_KN : OFF_VV))) + (size_t)r0 * 1024 + (g & 7) * 128 + l16 * 8;
    float fm[8], f0[8], fp[8];
    unpack8(rows[0], fm); unpack8(rows[1], f0);
#pragma unroll
    for (int i = 0; i < 8; ++i) {
      unpack8(rows[i + 2], fp);
      float y[8];
      float ss = 0.f;
#pragma unroll
      for (int k = 0; k < 8; ++k) { y[k] = silu(w0[k] * fm[k] + w1[k] * f0[k] + w2[k] * fp[k]); ss += y[k] * y[k]; }
      if (g < 16) {
        ss = grp16_sum(ss);
        float sc = rsqrtf(ss + 1e-6f);
        if (g < 8) sc *= 0.08838834764831845f;
#pragma unroll
        for (int k = 0; k < 8; ++k) y[k] *= sc;
      }
      uint4 o; o.x = pack2(y[0], y[1]); o.y = pack2(y[2], y[3]); o.z = pack2(y[4], y[5]); o.w = pack2(y[6], y[7]);
      *reinterpret_cast<uint4*>(dstb + (size_t)i * 1024) = o;
#pragma unroll
      for (int k = 0; k < 8; ++k) { fm[k] = f0[k]; f0[k] = fp[k]; }
    }
  }
}

struct SeqInfo { int base_row, L, nc, gc_base; };
DI SeqInfo seq_info(int seq) {
  SeqInfo s;
  if (seq < 16) { s.base_row = seq * 256; s.L = 256; s.nc = 4; s.gc_base = seq * 4; }
  else { s.base_row = 4096 + (seq - 16) * 1024; s.L = 1024; s.nc = 16; s.gc_base = 64 + (seq - 16) * 16; }
  return s;
}

DI void dn_chunk_phase(const Params& p, char* smem) {
  const int lane = threadIdx.x & 63, w = threadIdx.x >> 6, l16 = lane & 15, quad = lane >> 4;
  float* Lw = (float*)smem + w * (64 * 68);
  const u16* KN = (const u16*)(p.ws + OFF_KN);
  const float* GB = (const float*)(p.ws + OFF_GB);
  u16* TM = (u16*)(p.ws + OFF_TM);
  for (int tk = blockIdx.x * 4 + w; tk < 2048; tk += gridDim.x * 4) {
    const int dir = tk & 1, h = (tk >> 1) & 7, gc = tk >> 4;
    int base_row, L, c;
    if (gc < 64) { base_row = (gc >> 2) * 256; L = 256; c = gc & 3; }
    else { const int lc = gc - 64; base_row = 4096 + (lc >> 4) * 1024; L = 1024; c = lc & 15; }
    const int p0 = c * 64;
    const int tok_i = base_row + (dir ? (L - 1 - (p0 + lane)) : (p0 + lane));
    const float beta_i = GB[(size_t)tok_i * 32 + dir * 8 + h];
    float gcum = GB[(size_t)tok_i * 32 + 16 + dir * 8 + h];
#pragma unroll
    for (int o = 1; o < 64; o <<= 1) { float t = __shfl_up(gcum, o); if (lane >= o) gcum += t; }
    bf16x8 f[4][4];
#pragma unroll
    for (int mb = 0; mb < 4; ++mb) {
      const int pi = p0 + mb * 16 + l16;
      const int tok = base_row + (dir ? (L - 1 - pi) : pi);
#pragma unroll
      for (int ks = 0; ks < 4; ++ks) f[mb][ks] = ldf(KN + (size_t)tok * 1024 + h * 128 + ks * 32 + quad * 8);
    }
#pragma unroll
    for (int mb = 0; mb < 4; ++mb)
#pragma unroll
      for (int nb = 0; nb <= mb; ++nb) {
        f32x4 a = zero4();
#pragma unroll
        for (int ks = 0; ks < 4; ++ks) a = mfma(f[mb][ks], f[nb][ks], a);
        const int jj = nb * 16 + l16;
        const float gj = __shfl(gcum, jj);
#pragma unroll
        for (int j = 0; j < 4; ++j) {
          const int i = mb * 16 + quad * 4 + j;
          const float gi = __shfl(gcum, i), bi = __shfl(beta_i, i);
          Lw[i * 68 + jj] = (i > jj) ? bi * a[j] * __expf(gi - gj) : 0.f;
        }
      }
    __builtin_amdgcn_fence(__ATOMIC_RELEASE, "wavefront");
    __builtin_amdgcn_s_waitcnt(0xc07f);
    __builtin_amdgcn_wave_barrier();
    float t[64];
    u16* Tout = TM + (size_t)((dir * 8 + h) * 128 + gc) * 4096;
#pragma unroll
    for (int i = 0; i < 64; ++i) {
      float a = (i == lane) ? 1.f : 0.f;
#pragma unroll
      for (int j4 = 0; j4 < (i + 3) / 4; ++j4) {
        const float4 lv = *reinterpret_cast<const float4*>(Lw + i * 68 + j4 * 4);
        if (j4 * 4 + 0 < i) a -= lv.x * t[j4 * 4 + 0];
        if (j4 * 4 + 1 < i) a -= lv.y * t[j4 * 4 + 1];
        if (j4 * 4 + 2 < i) a -= lv.z * t[j4 * 4 + 2];
        if (j4 * 4 + 3 < i) a -= lv.w * t[j4 * 4 + 3];
      }
      t[i] = a;
      Tout[i * 64 + lane] = f2bf(a);
    }
    __builtin_amdgcn_wave_barrier();
  }
}

DI void dn_scan_task(const Params& p, char* smem, int seq, int h, int dir, int slice) {
  const int tid = threadIdx.x, lane = tid & 63, w = tid >> 6, l16 = lane & 15, quad = lane >> 4;
  u16* Ks = (u16*)smem;
  u16* Sb = Ks + 2 * 64 * 136;
  u16* Rt = Sb + 32 * 136;
  u16* Vn = Rt + 32 * 80;
  u16* Vs = Vn + 32 * 80;
  u16* Pl = Vs + 32 * 80;
  float* sg = (float*)(Pl + 64 * 80);
  float* sbt = sg + 128;
  const u16* QN = (const u16*)(p.ws + OFF_QN);
  const u16* KN = (const u16*)(p.ws + OFF_KN);
  const u16* VV = (const u16*)(p.ws + OFF_VV);
  const float* GB = (const float*)(p.ws + OFF_GB);
  const u16* TM = (const u16*)(p.ws + OFF_TM);
  u16* OFB = (u16*)(p.ws + OFF_OFB) + (size_t)dir * 8192 * 1024;
  const SeqInfo si = seq_info(seq);
  f32x4 Sacc[2][2];
  if (seq >= 16) {
    const float* s0 = p.in[6] + (size_t)(((seq - 16) * 2 + dir) * 8 + h) * 16384;
#pragma unroll
    for (int mb2 = 0; mb2 < 2; ++mb2)
#pragma unroll
      for (int nb = 0; nb < 2; ++nb)
#pragma unroll
        for (int j = 0; j < 4; ++j) Sacc[mb2][nb][j] = s0[(size_t)(32 * w + mb2 * 16 + quad * 4 + j) * 128 + slice * 32 + nb * 16 + l16];
  } else {
#pragma unroll
    for (int mb2 = 0; mb2 < 2; ++mb2)
#pragma unroll
      for (int nb = 0; nb < 2; ++nb) Sacc[mb2][nb] = zero4();
  }
  __syncthreads();
#pragma unroll
  for (int mb2 = 0; mb2 < 2; ++mb2)
#pragma unroll
    for (int nb = 0; nb < 2; ++nb) {
      uint2 pk; pk.x = pack2(Sacc[mb2][nb][0], Sacc[mb2][nb][1]); pk.y = pack2(Sacc[mb2][nb][2], Sacc[mb2][nb][3]);
      *reinterpret_cast<uint2*>(Sb + (nb * 16 + l16) * 136 + 32 * w + mb2 * 16 + quad * 4) = pk;
    }
  uint4 nk0, nk1, nk2, nk3; float ngr = 0.f, nbe = 0.f; bf16x8 nq0, nq1, nq2, nq3, nt0, nt1; u16 nv[2][4];
  const int krow = lane, kdc0 = 4 * w;
#define SCAN_TOK(pi_) (si.base_row + (dir ? (si.L - 1 - (pi_)) : (pi_)))
#define SCAN_FETCH(c_) do { \
    const int q0_ = (c_) * 64; \
    { const u16* kp_ = KN + (size_t)SCAN_TOK(q0_ + krow) * 1024 + h * 128 + kdc0 * 8; \
      nk0 = *reinterpret_cast<const uint4*>(kp_); nk1 = *reinterpret_cast<const uint4*>(kp_ + 8); \
      nk2 = *reinterpret_cast<const uint4*>(kp_ + 16); nk3 = *reinterpret_cast<const uint4*>(kp_ + 24); } \
    if (w == 0) { const int tk_ = SCAN_TOK(q0_ + lane); ngr = GB[(size_t)tk_ * 32 + 16 + dir * 8 + h]; nbe = GB[(size_t)tk_ * 32 + dir * 8 + h]; } \
    { const u16* qp_ = QN + (size_t)SCAN_TOK(q0_ + 16 * w + l16) * 1024 + h * 128 + quad * 8; \
      nq0 = ldf(qp_); nq1 = ldf(qp_ + 32); nq2 = ldf(qp_ + 64); nq3 = ldf(qp_ + 96); } \
    { const u16* tp_ = TM + (size_t)((dir * 8 + h) * 128 + si.gc_base + (c_)) * 4096 + (16 * w + l16) * 64 + quad * 8; \
      nt0 = ldf(tp_); nt1 = ldf(tp_ + 32); } \
    _Pragma("unroll") for (int j = 0; j < 4; ++j) { \
      const u16* vp_ = VV + (size_t)SCAN_TOK(q0_ + 16 * w + quad * 4 + j) * 1024 + h * 128 + slice * 32 + l16; \
      nv[0][j] = vp_[0]; nv[1][j] = vp_[16]; } \
  } while (0)
#define SCAN_KST(v_, i_, b_) do { \
    *reinterpret_cast<uint4*>(Ks + (b_) * 8704 + krow * 136 + (kdc0 + (i_)) * 8) = v_; \
  } while (0)
#define SCAN_STAGE(b_) do { \
    SCAN_KST(nk0, 0, b_); SCAN_KST(nk1, 1, b_); SCAN_KST(nk2, 2, b_); SCAN_KST(nk3, 3, b_); \
    if (w == 0) { \
      float gcum_ = ngr; \
      _Pragma("unroll") for (int o = 1; o < 64; o <<= 1) { float t_ = __shfl_up(gcum_, o); if (lane >= o) gcum_ += t_; } \
      sg[(b_) * 64 + lane] = gcum_; \
      sbt[(b_) * 64 + lane] = nbe; \
    } \
  } while (0)
  SCAN_FETCH(0);
  SCAN_STAGE(0);
  for (int c = 0; c < si.nc; ++c) {
    __syncthreads();
    const int p0 = c * 64;
    const u16* Kc = Ks + (c & 1) * 8704;
    const float* sgc = sg + (c & 1) * 64;
    const float* sbc = sbt + (c & 1) * 64;
    bf16x8 qf[4], tf[2];
    qf[0] = nq0; qf[1] = nq1; qf[2] = nq2; qf[3] = nq3; tf[0] = nt0; tf[1] = nt1;
    float vv[2][4];
#pragma unroll
    for (int j = 0; j < 4; ++j) { vv[0][j] = bf2f(nv[0][j]); vv[1][j] = bf2f(nv[1][j]); }
    if (c + 1 < si.nc) SCAN_FETCH(c + 1);
    f32x4 QS[2], KS[2];
#pragma unroll
    for (int nb = 0; nb < 2; ++nb) { QS[nb] = zero4(); KS[nb] = zero4(); }
#pragma unroll
    for (int ks = 0; ks < 4; ++ks) {
      const bf16x8 kfr = ldf(Kc + (16 * w + l16) * 136 + ks * 32 + quad * 8);
#pragma unroll
      for (int nb = 0; nb < 2; ++nb) {
        bf16x8 sf = ldf(Sb + (nb * 16 + l16) * 136 + ks * 32 + quad * 8);
        QS[nb] = mfma(qf[ks], sf, QS[nb]);
        KS[nb] = mfma(kfr, sf, KS[nb]);
      }
    }
    float gi[4], bi[4], egi[4];
    const float glast = sgc[63];
#pragma unroll
    for (int j = 0; j < 4; ++j) { gi[j] = sgc[16 * w + quad * 4 + j]; bi[j] = sbc[16 * w + quad * 4 + j]; egi[j] = __expf(gi[j]); }
#pragma unroll
    for (int nb = 0; nb < 2; ++nb) {
      float r0 = bi[0] * (vv[nb][0] - egi[0] * KS[nb][0]);
      float r1 = bi[1] * (vv[nb][1] - egi[1] * KS[nb][1]);
      float r2 = bi[2] * (vv[nb][2] - egi[2] * KS[nb][2]);
      float r3 = bi[3] * (vv[nb][3] - egi[3] * KS[nb][3]);
      uint2 pk; pk.x = pack2(r0, r1); pk.y = pack2(r2, r3);
      *reinterpret_cast<uint2*>(Rt + (nb * 16 + l16) * 80 + 16 * w + quad * 4) = pk;
    }
    bf16x8 Pf[2];
    {
      const int icol = 16 * w + l16;
      const float gic = sgc[icol];
      f32x4 pt[4];
#pragma unroll
      for (int nb4 = 0; nb4 < 4; ++nb4) {
        pt[nb4] = zero4();
        if (nb4 <= w) {
#pragma unroll
          for (int ks = 0; ks < 4; ++ks) pt[nb4] = mfma(ldf(Kc + (nb4 * 16 + l16) * 136 + ks * 32 + quad * 8), qf[ks], pt[nb4]);
        }
        const float4 gj4 = *reinterpret_cast<const float4*>(sgc + nb4 * 16 + quad * 4);
        const int jj0 = nb4 * 16 + quad * 4;
        pt[nb4][0] = (nb4 <= w && icol >= jj0 + 0) ? pt[nb4][0] * __expf(gic - gj4.x) : 0.f;
        pt[nb4][1] = (nb4 <= w && icol >= jj0 + 1) ? pt[nb4][1] * __expf(gic - gj4.y) : 0.f;
        pt[nb4][2] = (nb4 <= w && icol >= jj0 + 2) ? pt[nb4][2] * __expf(gic - gj4.z) : 0.f;
        pt[nb4][3] = (nb4 <= w && icol >= jj0 + 3) ? pt[nb4][3] * __expf(gic - gj4.w) : 0.f;
      }
#pragma unroll
      for (int k2 = 0; k2 < 2; ++k2) {
        uint4 u;
        u.x = pack2(pt[2 * k2][0], pt[2 * k2][1]); u.y = pack2(pt[2 * k2][2], pt[2 * k2][3]);
        u.z = pack2(pt[2 * k2 + 1][0], pt[2 * k2 + 1][1]); u.w = pack2(pt[2 * k2 + 1][2], pt[2 * k2 + 1][3]);
        Pf[k2] = __builtin_bit_cast(bf16x8, u);
      }
    }
    __syncthreads();
    f32x4 VN[2];
#pragma unroll
    for (int nb = 0; nb < 2; ++nb) {
      VN[nb] = zero4();
#pragma unroll
      for (int k2 = 0; k2 < 2; ++k2) VN[nb] = mfma(tf[k2], ldf(Rt + (nb * 16 + l16) * 80 + k2 * 32 + quad * 8), VN[nb]);
      uint2 pk, ps;
      pk.x = pack2(VN[nb][0], VN[nb][1]); pk.y = pack2(VN[nb][2], VN[nb][3]);
      ps.x = pack2(VN[nb][0] * __expf(glast - gi[0]), VN[nb][1] * __expf(glast - gi[1]));
      ps.y = pack2(VN[nb][2] * __expf(glast - gi[2]), VN[nb][3] * __expf(glast - gi[3]));
      *reinterpret_cast<uint2*>(Vn + (nb * 16 + l16) * 80 + (w >> 1) * 32 + quad * 8 + (w & 1) * 4) = pk;
      *reinterpret_cast<uint2*>(Vs + (nb * 16 + l16) * 80 + 16 * w + quad * 4) = ps;
    }
    __syncthreads();
#pragma unroll
    for (int nb = 0; nb < 2; ++nb) {
      f32x4 oi = zero4();
#pragma unroll
      for (int k2 = 0; k2 < 2; ++k2)
        oi = mfma(Pf[k2], ldf(Vn + (nb * 16 + l16) * 80 + k2 * 32 + quad * 8), oi);
#pragma unroll
      for (int j = 0; j < 4; ++j) {
        const int pi = p0 + 16 * w + quad * 4 + j;
        const int tok = si.base_row + (dir ? (si.L - 1 - pi) : pi);
        OFB[(size_t)tok * 1024 + h * 128 + slice * 32 + nb * 16 + l16] = f2bf(egi[j] * QS[nb][j] + oi[j]);
      }
    }
    const float eg = __expf(glast);
    bf16x8 ktf[2][2];
    {
      typedef short s16x4_t __attribute__((ext_vector_type(4)));
      const unsigned kta = (unsigned)(size_t)(Kc + (quad * 8 + (l16 >> 2)) * 136 + 32 * w + 4 * (l16 & 3));
      s16x4_t t00l, t00h, t01l, t01h, t10l, t10h, t11l, t11h;
      asm volatile(
          "ds_read_b64_tr_b16 %0, %8\n\t"
          "ds_read_b64_tr_b16 %1, %8 offset:1088\n\t"
          "ds_read_b64_tr_b16 %2, %8 offset:8704\n\t"
          "ds_read_b64_tr_b16 %3, %8 offset:9792\n\t"
          "ds_read_b64_tr_b16 %4, %8 offset:32\n\t"
          "ds_read_b64_tr_b16 %5, %8 offset:1120\n\t"
          "ds_read_b64_tr_b16 %6, %8 offset:8736\n\t"
          "ds_read_b64_tr_b16 %7, %8 offset:9824\n\t"
          "s_waitcnt lgkmcnt(0)"
          : "=&v"(t00l), "=&v"(t00h), "=&v"(t01l), "=&v"(t01h), "=&v"(t10l), "=&v"(t10h), "=&v"(t11l), "=&v"(t11h)
          : "v"(kta) : "memory");
      ktf[0][0] = __builtin_shufflevector(t00l, t00h, 0, 1, 2, 3, 4, 5, 6, 7);
      ktf[0][1] = __builtin_shufflevector(t01l, t01h, 0, 1, 2, 3, 4, 5, 6, 7);
      ktf[1][0] = __builtin_shufflevector(t10l, t10h, 0, 1, 2, 3, 4, 5, 6, 7);
      ktf[1][1] = __builtin_shufflevector(t11l, t11h, 0, 1, 2, 3, 4, 5, 6, 7);
    }
#pragma unroll
    for (int mb2 = 0; mb2 < 2; ++mb2)
#pragma unroll
      for (int nb = 0; nb < 2; ++nb) {
        f32x4 a = Sacc[mb2][nb];
        a[0] *= eg; a[1] *= eg; a[2] *= eg; a[3] *= eg;
#pragma unroll
        for (int k2 = 0; k2 < 2; ++k2)
          a = mfma(ktf[mb2][k2], ldf(Vs + (nb * 16 + l16) * 80 + k2 * 32 + quad * 8), a);
        Sacc[mb2][nb] = a;
        uint2 pk; pk.x = pack2(a[0], a[1]); pk.y = pack2(a[2], a[3]);
        *reinterpret_cast<uint2*>(Sb + (nb * 16 + l16) * 136 + 32 * w + mb2 * 16 + quad * 4) = pk;
      }
    if (c + 1 < si.nc) SCAN_STAGE((c + 1) & 1);
  }
  if (seq < 16) {
    float* so = p.out + OUT_L2S + (size_t)((seq * 2 + dir) * 8 + h) * 16384;
#pragma unroll
    for (int mb2 = 0; mb2 < 2; ++mb2)
#pragma unroll
      for (int nb = 0; nb < 2; ++nb)
#pragma unroll
        for (int j = 0; j < 4; ++j) so[(size_t)(32 * w + mb2 * 16 + quad * 4 + j) * 128 + slice * 32 + nb * 16 + l16] = Sacc[mb2][nb][j];
  }
}

#undef SCAN_TOK
#undef SCAN_FETCH
#undef SCAN_KST
#undef SCAN_STAGE
DI void dn_scan_phase(const Params& p, char* smem) {
  for (int unit = blockIdx.x; unit < 512; unit += gridDim.x) {
    const int ntask = unit < 256 ? 1 : 4;
    for (int q = 0; q < ntask; ++q) {
      int seq, code;
      if (unit < 256) { const int u = (unit & 7) * 32 + (unit >> 3); seq = 16 + (u >> 6); code = u & 63; }
      else { const int u0 = unit - 256; const int u = (u0 & 7) * 32 + (u0 >> 3); const int ct = u * 4 + q; seq = ct >> 6; code = ct & 63; }
      dn_scan_task(p, smem, seq, (code >> 3) & 7, (code >> 2) & 1, code & 3);
    }
  }
}

DI void dn_out_phase(const Params& p) {
  const int lane = threadIdx.x & 63, w = threadIdx.x >> 6, l16 = lane & 15, hs = lane >> 4;
  const u16* OF = (const u16*)(p.ws + OFF_OFB);
  const u16* OB = OF + (size_t)8192 * 1024;
  const u16* PR = (const u16*)(p.ws + OFF_PR);
  u16* OG = (u16*)(p.ws + OFF_H);
  float gw[8];
  {
    const float4 a = *reinterpret_cast<const float4*>(p.in[35] + l16 * 8), b = *reinterpret_cast<const float4*>(p.in[35] + l16 * 8 + 4);
    gw[0] = a.x; gw[1] = a.y; gw[2] = a.z; gw[3] = a.w; gw[4] = b.x; gw[5] = b.y; gw[6] = b.z; gw[7] = b.w;
  }
  for (int task = blockIdx.x * 4 + w; task < 4096; task += gridDim.x * 4) {
    uint4 a[4], b[4], z[4];
#pragma unroll
    for (int u = 0; u < 4; ++u) {
      const int r = task * 2 + (u >> 1), h = (u & 1) * 4 + hs;
      const size_t off = (size_t)r * 1024 + h * 128 + l16 * 8;
      a[u] = *reinterpret_cast<const uint4*>(OF + off);
      b[u] = *reinterpret_cast<const uint4*>(OB + off);
      z[u] = *reinterpret_cast<const uint4*>(PR + (size_t)r * 4224 + 3072 + h * 128 + l16 * 8);
    }
#pragma unroll
    for (int u = 0; u < 4; ++u) {
      const int r = task * 2 + (u >> 1), h = (u & 1) * 4 + hs;
      float fa[8], fb[8], fz[8];
      unpack8(a[u], fa); unpack8(b[u], fb); unpack8(z[u], fz);
      float ss = 0.f;
#pragma unroll
      for (int k = 0; k < 8; ++k) { fa[k] += fb[k]; ss += fa[k] * fa[k]; }
      ss = grp16_sum(ss);
      const float rs = rsqrtf(ss * (1.f / 128.f) + NORM_EPS);
#pragma unroll
      for (int k = 0; k < 8; ++k) fa[k] = fa[k] * rs * gw[k] * silu(fz[k]);
      uint4 o; o.x = pack2(fa[0], fa[1]); o.y = pack2(fa[2], fa[3]); o.z = pack2(fa[4], fa[5]); o.w = pack2(fa[6], fa[7]);
      *reinterpret_cast<uint4*>(OG + (size_t)r * 1024 + h * 128 + l16 * 8) = o;
    }
  }
}

#define XB_TMO      128
#define XB_XCNT(j)  (256  + 64 * (j))
#define XB_XSUB(j)  (1280 + 64 * (j))
#define XB_XGEN(j)  (2304 + 64 * (j))
#define XB_TOP      3328
#define XB_TOPGEN   3392
#define XCD_BAR_WORDS 3456
#define XB_SPIN_CAP (1u << 20)
#define LAS __attribute__((address_space(3)))
DI unsigned xb_ld(unsigned* p)              { return __hip_atomic_load(p, __ATOMIC_RELAXED, __HIP_MEMORY_SCOPE_AGENT); }
DI unsigned xb_add(unsigned* p, unsigned v) { return __hip_atomic_fetch_add(p, v, __ATOMIC_RELAXED, __HIP_MEMORY_SCOPE_AGENT); }
DI unsigned xb_xcc_id() { return (unsigned)__builtin_amdgcn_s_getreg((3 << 11) | 20) & 0xFu; }
#define XB_SPIN(cond, bar) do { unsigned _sp = 0; while (cond) { __builtin_amdgcn_s_sleep(1); \
    if ((++_sp & 255u) == 0u) { if (xb_ld(&(bar)[XB_TMO])) break; if (_sp > XB_SPIN_CAP) { atomicAdd(&(bar)[XB_TMO], 1u); break; } } } } while (0)
struct XcdBarrier { unsigned* bar; unsigned x; volatile LAS unsigned* st; };
DI XcdBarrier xcd_barrier_post(unsigned* bar, volatile LAS unsigned* st) {
  XcdBarrier b; b.bar = bar; b.x = xb_xcc_id(); b.st = st;
  if (threadIdx.x == 0) (void)xb_add(&bar[XB_XCNT(b.x)], 1u);
  return b;
}
DI void xcd_barrier_complete(unsigned* bar, unsigned x, unsigned& nloc, unsigned& nx) {
  const unsigned G = gridDim.x * gridDim.y * gridDim.z;
  unsigned sum, cnt, mine, sp = 0u;
  for (;;) {
    sum = 0u; cnt = 0u; mine = 0u;
#pragma unroll
    for (unsigned j = 0; j < 16; ++j) { const unsigned c = xb_ld(&bar[XB_XCNT(j)]); sum += c; cnt += (c > 0u) ? 1u : 0u; mine = (j == x) ? c : mine; }
    if (sum == G) break;
    __builtin_amdgcn_s_sleep(1);
    if ((++sp & 255u) == 0u) { if (xb_ld(&bar[XB_TMO])) break; if (sp > XB_SPIN_CAP) { atomicAdd(&bar[XB_TMO], 1u); break; } }
  }
  nloc = mine > 0u ? mine : 1u; nx = cnt > 0u ? cnt : 1u;
}
DI void xcd_barrier(const XcdBarrier& b) {
  asm volatile("s_waitcnt vmcnt(0)" ::: "memory");
  __syncthreads();
  if (threadIdx.x == 0) {
    unsigned* bar = b.bar;
    __builtin_amdgcn_s_waitcnt(0);
    unsigned nloc = b.st[0], nx = b.st[1];
    if (nloc == 0u) { xcd_barrier_complete(bar, b.x, nloc, nx); b.st[0] = nloc; b.st[1] = nx; }
    const unsigned old = xb_add(&bar[XB_XSUB(b.x)], 1u);
    const unsigned gen = old / nloc;
    if (old + 1u == (gen + 1u) * nloc) {
      __builtin_amdgcn_fence(__ATOMIC_RELEASE, "agent");
      asm volatile("s_waitcnt vmcnt(0)" ::: "memory");
      const unsigned og = xb_add(&bar[XB_TOP], 1u);
      const unsigned tg = og / nx;
      if (og + 1u == (tg + 1u) * nx) xb_add(&bar[XB_TOPGEN], 1u);
      else XB_SPIN(xb_ld(&bar[XB_TOPGEN]) == tg, bar);
      __builtin_amdgcn_fence(__ATOMIC_ACQUIRE, "agent");
      xb_add(&bar[XB_XGEN(b.x)], 1u);
      asm volatile("s_waitcnt vmcnt(0)" ::: "memory");
    } else {
      XB_SPIN(xb_ld(&bar[XB_XGEN(b.x)]) == gen, bar);
      __builtin_amdgcn_fence(__ATOMIC_ACQUIRE, "agent");
      asm volatile("s_waitcnt vmcnt(0)" ::: "memory");
    }
  }
  __syncthreads();
}

DI void gemm_for(const Params& p, char* smem, int layer, int which) {
  const u16* H = (const u16*)(p.ws + OFF_H);
  EpiArgs e;
  const u16* WT;
  int ntn;
  e.layer = layer;
  if (which >= 1) {
    e.kind = which == 1 ? 2 : 3; e.ld = 0; e.rope_end = 0; e.k_beg = 0; e.k_end = 0; e.v_end = 0; e.kw = 0; e.outk = nullptr; e.outv = nullptr;
    WT = (const u16*)(p.ws + OFF_WTOUT + (size_t)layer * 2097152); ntn = 8;
  } else if (layer == 1) {
    e.kind = 0; e.ld = 4096; e.rope_end = 2048; e.k_beg = 1024; e.k_end = 2048; e.v_end = 3072; e.kw = 1024;
    e.outk = p.out + OUT_L1K; e.outv = p.out + OUT_L1V;
    WT = (const u16*)(p.ws + OFF_WTIN + WTIN_L1); ntn = 32;
  } else if (layer == 2) {
    e.kind = 1; e.ld = 4224; e.rope_end = 0; e.k_beg = 0; e.k_end = 0; e.v_end = 0; e.kw = 0; e.outk = nullptr; e.outv = nullptr;
    WT = (const u16*)(p.ws + OFF_WTIN + WTIN_L2); ntn = 32;
  } else {
    e.kind = 0; e.ld = 2560; e.rope_end = 1280; e.k_beg = 1024; e.k_end = 1280; e.v_end = 1536; e.kw = 256;
    e.outk = p.out + (layer == 0 ? OUT_L0K : OUT_L3K); e.outv = p.out + (layer == 0 ? OUT_L0V : OUT_L3V);
    WT = (const u16*)(p.ws + OFF_WTIN + (layer == 0 ? WTIN_L0 : WTIN_L3)); ntn = 20;
  }
  e.fused = (which == 0) ? (layer >= 1) : (which == 1 && layer < 3);
  const u16* A = (which == 0 && layer >= 1) ? (const u16*)(p.ws + OFF_HR) : H;
  gemm_phase(p, smem, A, WT, ntn, e);
}

constexpr int NPHASE = 30;
DI void run_phase(const Params& p, char* smem, int ph) {
  if (ph == 0) { phase0(p, smem); return; }
  if (ph == 29) { norm_phase(p, 4); return; }
  const int l = (ph - 1) / 7, s = (ph - 1) % 7;
  if (s == 0) norm_phase(p, l);
  else if (s == 1) gemm_for(p, smem, l, 0);
  else if (s == 6) gemm_for(p, smem, l, 1);
  else if (l == 2) {
    if (s == 2) dn_conv_phase(p);
    else if (s == 3) dn_chunk_phase(p, smem);
    else if (s == 4) dn_scan_phase(p, smem);
    else dn_out_phase(p);
  } else if (s == 2) {
    if (l == 1) attn_b_phase(p, smem); else attn_a_phase(p, smem, l);
  }
}
DI bool phase_empty(int ph) {
  if (ph == 0 || ph == 29) return false;
  const int l = (ph - 1) / 7, s = (ph - 1) % 7;
  return (l != 2) && (s >= 3 && s <= 5);
}

#if ONE_LAUNCH
__global__ void __launch_bounds__(256, 2) mega_kernel(Params p) {
  __shared__ __attribute__((aligned(16))) char smem[SMEM_BYTES];
  cg::grid_group grid = cg::this_grid();
  __shared__ uint4 xb_words;
  if (threadIdx.x == 0) xb_words = make_uint4(0u, 0u, 0u, 0u);
  __syncthreads();
  XcdBarrier xb = xcd_barrier_post((unsigned*)(p.ws + OFF_BAR), (volatile LAS unsigned*)&xb_words);
  if (p.ws == nullptr) grid.sync();
#define REP_0(x) x;
#define REP_1(x) x; x;
#define REP_I(n, x) REP_##n(x)
#define REP(n, x) REP_I(n, x)
#define GSYNC REP(DUP_SYNC, xcd_barrier(xb))
  REP(DUP_P0, phase0(p, smem)) GSYNC;
  REP(DUP_NORM, norm_phase(p, 0)) sw_tasks(p); GSYNC;
  REP(DUP_GEMM, gemm_for(p, smem, 0, 0)) GSYNC;
  REP(DUP_ATT, attn_a_phase(p, smem, 0)) GSYNC;
  gemm_for(p, smem, 0, 1);
#if DUP_OUT
  gemm_for(p, smem, 0, 2);
#endif
  GSYNC;
  REP(DUP_GEMM, gemm_for(p, smem, 1, 0)) GSYNC;
  REP(DUP_DN2, attn_b_phase(p, smem)) GSYNC;
  gemm_for(p, smem, 1, 1);
#if DUP_OUT
  gemm_for(p, smem, 1, 2);
#endif
  GSYNC;
  REP(DUP_GEMM, gemm_for(p, smem, 2, 0)) GSYNC;
  REP(DUP_DN, dn_conv_phase(p)) GSYNC;
  REP(DUP_DN, dn_chunk_phase(p, smem)) GSYNC;
  REP(DUP_DN, dn_scan_phase(p, smem)) GSYNC;
  REP(DUP_DN, dn_out_phase(p)) GSYNC;
  gemm_for(p, smem, 2, 1);
#if DUP_OUT
  gemm_for(p, smem, 2, 2);
#endif
  GSYNC;
  REP(DUP_GEMM, gemm_for(p, smem, 3, 0)) GSYNC;
  REP(DUP_ATT, attn_a_phase(p, smem, 3)) GSYNC;
  gemm_for(p, smem, 3, 1);
#if DUP_OUT
  gemm_for(p, smem, 3, 2);
#endif
  GSYNC;
  REP(DUP_NORM, norm_phase(p, 4))
}
#else
__global__ void __launch_bounds__(256, 2) phase_kernel(Params p, int ph) {
  __shared__ __attribute__((aligned(16))) char smem[SMEM_BYTES];
  run_phase(p, smem, ph);
}
#endif

extern "C" void kernel_launch(void* const* d_in, const int* in_sizes, int n_in, void* d_out, int out_size, void* d_ws, size_t ws_size,
                              hipStream_t stream) {
  if (n_in != 43 || ws_size < WS_END) { fprintf(stderr, "kernel_launch: unexpected n_in %d / ws_size %zu\n", n_in, ws_size); return; }
  Params p{};
  for (int i = 0; i < 43; ++i) p.in[i] = (const float*)d_in[i];
  p.out = (float*)d_out;
  p.ws = (char*)d_ws;
#if ONE_LAUNCH
  static int grid_blocks = 0;
  if (!grid_blocks) {
    int dev = 0, cus = 0, per_cu = 0;
    hipGetDevice(&dev);
    hipDeviceGetAttribute(&cus, hipDeviceAttributeMultiprocessorCount, dev);
    hipOccupancyMaxActiveBlocksPerMultiprocessor(&per_cu, mega_kernel, 256, 0);
    if (per_cu < 1) per_cu = 1;
    if (per_cu > 2) per_cu = 2;
    grid_blocks = cus * per_cu;
  }
  (void)hipMemsetAsync((char*)d_ws + OFF_BAR, 0, 16384, stream);
  void* args[] = {&p};
  hipError_t e = hipLaunchCooperativeKernel((void*)mega_kernel, dim3(grid_blocks), dim3(256), args, 0, stream);
  if (e != hipSuccess) fprintf(stderr, "cooperative launch failed: %s (grid %d)\n", hipGetErrorString(e), grid_blocks);
#else
  for (int ph = 0; ph < NPHASE; ++ph) { bool empty = (ph != 0 && ph != 29) && ((ph - 1) / 7 != 2) && ((ph - 1) % 7 >= 3 && (ph - 1) % 7 <= 5); if (!empty) phase_kernel<<<512, 256, 0, stream>>>(p, ph); }
#endif
}
```

```cpp
#include <hip/hip_runtime.h>
#include <hip/hip_bf16.h>
#include <hip/hip_cooperative_groups.h>
#include <cstdio>
namespace cg = cooperative_groups;

#define ONE_LAUNCH 1
#define DUP_P0 0
#define DUP_GEMM 0
#define DUP_ATT 0
#define DUP_DN 0
#define DUP_DN2 0
#define DUP_SYNC 0
#define DUP_NORM 0
#define DUP_OUT 0

typedef unsigned short u16;
using bf16x8 = __attribute__((ext_vector_type(8))) short;
using f32x4 = __attribute__((ext_vector_type(4))) float;
#define DI __device__ __forceinline__

constexpr size_t OFF_X    = 0;
constexpr size_t OFF_H    = OFF_X + 33554432;
constexpr size_t OFF_PR   = OFF_H + 16777216;
constexpr size_t OFF_WTIN = OFF_PR + 69206016;
constexpr size_t WTIN_L0 = 0, WTIN_L1 = 5242880, WTIN_L2 = WTIN_L1 + 8388608, WTIN_L3 = WTIN_L2 + 8650752;
constexpr size_t OFF_WTOUT = OFF_WTIN + 27525120;
constexpr size_t OFF_QN   = OFF_WTOUT + 8388608;
constexpr size_t OFF_KN   = OFF_QN + 16777216;
constexpr size_t OFF_VV   = OFF_KN + 16777216;
constexpr size_t OFF_TM   = OFF_VV + 16777216;
constexpr size_t OFF_OFB  = OFF_TM + 16777216;
constexpr size_t OFF_MOD  = OFF_OFB + 33554432;
constexpr size_t OFF_GATES= OFF_MOD + 245760;
constexpr size_t OFF_GB   = OFF_GATES + 1048576;
constexpr size_t OFF_ROPE = OFF_GB + 1048576;
constexpr size_t OFF_LAM  = OFF_ROPE + 8192;
constexpr size_t OFF_BAR  = OFF_LAM + 256;
constexpr size_t OFF_CK0  = OFF_BAR + 16384;
constexpr size_t OFF_CV0  = OFF_CK0 + 1048576;
constexpr size_t OFF_CK3  = OFF_CV0 + 1048576;
constexpr size_t OFF_CV3  = OFF_CK3 + 1048576;
constexpr size_t OFF_SS   = OFF_CV3 + 1048576;
constexpr size_t OFF_SW   = OFF_SS + 131072;
constexpr size_t WS_END   = OFF_SW + 337920;
constexpr size_t OFF_HR   = OFF_OFB + 8388608;
constexpr size_t OFF_CK1  = OFF_OFB;
constexpr size_t OFF_CV1  = OFF_OFB + 4194304;
constexpr size_t OFF_VT   = OFF_VV;

constexpr size_t OUT_Y = 0, OUT_L0K = 8388608, OUT_L0V = 9437184, OUT_L1K = 10485760, OUT_L1V = 14680064,
                 OUT_L2S = 18874368, OUT_L3K = 23068672, OUT_L3V = 24117248;

constexpr int SMEM_BYTES = 77824;
constexpr float NORM_EPS = 1e-6f;

struct Params {
  const float* in[43];
  float* out;
  char* ws;
};

__host__ __device__ constexpr int lbase(int l) { return l == 0 ? 11 : (l == 1 ? 17 : (l == 2 ? 27 : 36)); }

typedef __bf16 bf16x2_t __attribute__((ext_vector_type(2)));
typedef float f32x2_t __attribute__((ext_vector_type(2)));
DI u16 f2bf(float x) { __bf16 b = (__bf16)x; return __builtin_bit_cast(u16, b); }
DI float bf2f(u16 h) { return __uint_as_float(((unsigned)h) << 16); }
DI unsigned pack2(float a, float b) { f32x2_t v = {a, b}; bf16x2_t r = __builtin_convertvector(v, bf16x2_t); return __builtin_bit_cast(unsigned, r); }
DI float silu(float x) { return x / (1.f + __expf(-x)); }
DI float wave_sum(float v) { for (int o = 32; o; o >>= 1) v += __shfl_xor(v, o); return v; }
DI float grp16_sum(float v) { v += __shfl_xor(v, 1); v += __shfl_xor(v, 2); v += __shfl_xor(v, 4); v += __shfl_xor(v, 8); return v; }
DI float grp16_max(float v) { v = fmaxf(v, __shfl_xor(v, 1)); v = fmaxf(v, __shfl_xor(v, 2)); v = fmaxf(v, __shfl_xor(v, 4)); v = fmaxf(v, __shfl_xor(v, 8)); return v; }
DI f32x4 mfma(bf16x8 a, bf16x8 b, f32x4 c) { return __builtin_amdgcn_mfma_f32_16x16x32_bf16(a, b, c, 0, 0, 0); }
DI bf16x8 ldf(const u16* p) { return *reinterpret_cast<const bf16x8*>(p); }
DI f32x4 zero4() { f32x4 z = {0.f, 0.f, 0.f, 0.f}; return z; }
DI float4 ntload4(const float* p) { const f32x4 v = __builtin_nontemporal_load(reinterpret_cast<const f32x4*>(p)); return make_float4(v[0], v[1], v[2], v[3]); }
typedef unsigned u32x4_t __attribute__((ext_vector_type(4)));
DI uint4 ntload_u4(const void* p) { const u32x4_t v = __builtin_nontemporal_load(reinterpret_cast<const u32x4_t*>(p)); return make_uint4(v[0], v[1], v[2], v[3]); }
DI void ntstore4(float* p, float4 o) { f32x4 v = {o.x, o.y, o.z, o.w}; __builtin_nontemporal_store(v, reinterpret_cast<f32x4*>(p)); }

DI void phase0(const Params& p, char* smem) {
  const int tid = threadIdx.x;
  constexpr int NT_MOD = 384, NT_TR = 1680 + 512 + 384, NT_CK = 768;
  for (int task = blockIdx.x; task < NT_MOD + NT_TR + NT_CK + 1; task += gridDim.x) {
    __syncthreads();
    if (task < NT_MOD) {
      const int l = task / 96, cgp = task % 96;
      float* sc = (float*)smem;
      float* red = sc + 5 * 1024;
      for (int i = tid; i < 5 * 1024; i += 256) {
        int c = i >> 10, k = i & 1023;
        float v = (c == 0) ? p.in[10][k] : p.in[9][(c - 1) * 1024 + k];
        sc[i] = v / (1.f + expf(-v));
      }
      __syncthreads();
      const float* W = p.in[lbase(l) + 1];
      const float* mb = p.in[lbase(l) + 2];
      const int kg = tid >> 3, cp = tid & 7, n = cgp * 32 + cp * 4;
      float4 a[5];
#pragma unroll
      for (int c = 0; c < 5; ++c) a[c] = make_float4(0.f, 0.f, 0.f, 0.f);
      const float* wp = W + (size_t)(kg * 32) * 3072 + n;
#pragma unroll 16
      for (int k = 0; k < 32; ++k) {
        const float4 wv = ntload4(wp + (size_t)k * 3072);
#pragma unroll
        for (int c = 0; c < 5; ++c) { const float s = sc[c * 1024 + kg * 32 + k]; a[c].x += s * wv.x; a[c].y += s * wv.y; a[c].z += s * wv.z; a[c].w += s * wv.w; }
      }
#pragma unroll
      for (int c = 0; c < 5; ++c) *reinterpret_cast<float4*>(red + (kg * 5 + c) * 32 + cp * 4) = a[c];
      __syncthreads();
      float* MOD = (float*)(p.ws + OFF_MOD);
      if (tid < 160) {
        const int c = tid >> 5, col = tid & 31;
        float s = 0.f;
#pragma unroll
        for (int g = 0; g < 32; ++g) s += red[(g * 5 + c) * 32 + col];
        s += mb[cgp * 32 + col];
        MOD[(l * 5 + c) * 3072 + cgp * 32 + col] = s;
      }
    } else if (task < NT_MOD + NT_TR) {
      int tt = task - NT_MOD;
      const float* W; u16* WT; int N, sld, dld, kt, nt; bool vperm = false;
      if (tt < 1680) {
        int l, local, nn;
        if (tt < 320) { l = 0; local = tt; nn = 20; N = 2560; WT = (u16*)(p.ws + OFF_WTIN + WTIN_L0); }
        else if (tt < 832) { l = 1; local = tt - 320; nn = 32; N = 4096; WT = (u16*)(p.ws + OFF_WTIN + WTIN_L1); }
        else if (tt < 1360) { l = 2; local = tt - 832; nn = 33; N = 4128; WT = (u16*)(p.ws + OFF_WTIN + WTIN_L2); }
        else { l = 3; local = tt - 1360; nn = 20; N = 2560; WT = (u16*)(p.ws + OFF_WTIN + WTIN_L3); }
        W = p.in[lbase(l) + 3]; sld = N; dld = 1024;
        nt = (local % nn) * 2; kt = local / nn;
      } else if (tt < 2192) {
        int t2 = tt - 1680; int l = t2 >> 7; int local = t2 & 127;
        W = p.in[lbase(l) + 4]; WT = (u16*)(p.ws + OFF_WTOUT + (size_t)l * 2097152); N = 1024; sld = 1024; dld = 1024;
        nt = (local & 7) * 2; kt = local >> 3;
      } else {
        int t3 = tt - 2192, F, local; size_t doff;
        if (t3 < 64) { W = p.in[3]; F = 256; local = t3; doff = OFF_CV0; }
        else if (t3 < 128) { W = p.in[8]; F = 256; local = t3 - 64; doff = OFF_CV3; }
        else { W = p.in[5]; F = 1024; local = t3 - 128; doff = OFF_CV1; }
        const int per_b = 8 * (F / 128);
        const int b = local / per_b, r = local % per_b;
        kt = r & 7; nt = (r >> 3) * 2;
        W += (size_t)b * 512 * F; WT = (u16*)(p.ws + doff) + (size_t)b * F * 512; N = F; sld = F; dld = 512; vperm = true;
      }
      float* tl = (float*)smem;
      {
        const int kk0 = tid >> 4, nn = (tid & 15) * 4;
        float4 v4[2][4];
#pragma unroll
        for (int hh = 0; hh < 2; ++hh) {
          const int n = (nt + hh) * 64 + nn;
#pragma unroll
          for (int i = 0; i < 4; ++i)
            v4[hh][i] = (n < N) ? ntload4(W + (size_t)(kt * 64 + kk0 + 16 * i) * sld + n) : make_float4(0.f, 0.f, 0.f, 0.f);
        }
#pragma unroll
        for (int hh = 0; hh < 2; ++hh)
#pragma unroll
          for (int i = 0; i < 4; ++i) {
            float* d = tl + hh * 4160 + (kk0 + 16 * i) * 65 + nn;
            d[0] = v4[hh][i].x; d[1] = v4[hh][i].y; d[2] = v4[hh][i].z; d[3] = v4[hh][i].w;
          }
      }
      __syncthreads();
#pragma unroll
      for (int hh = 0; hh < 2; ++hh)
#pragma unroll
        for (int i = 0; i < 2; ++i) {
          const int nn = i * 32 + (tid >> 3), kc = tid & 7;
          const float* s = tl + hh * 4160 + (kc * 8) * 65 + nn;
          uint4 o;
          o.x = pack2(s[0], s[65]); o.y = pack2(s[130], s[195]); o.z = pack2(s[260], s[325]); o.w = pack2(s[390], s[455]);
          u16* dp = WT + (size_t)((nt + hh) * 64 + nn) * dld + kt * 64;
          if (vperm) {
            const int pb = (kc >> 2) * 32 + ((kc & 3) >> 1) * 4 + (kc & 1) * 16;
            uint2 lo2; lo2.x = o.x; lo2.y = o.y; uint2 hi2; hi2.x = o.z; hi2.y = o.w;
            *reinterpret_cast<uint2*>(dp + pb) = lo2;
            *reinterpret_cast<uint2*>(dp + pb + 8) = hi2;
          } else {
            *reinterpret_cast<uint4*>(dp + kc * 8) = o;
          }
        }
    } else if (task < NT_MOD + NT_TR + NT_CK) {
      int t4 = task - NT_MOD - NT_TR;
      const float* s; u16* d;
      if (t4 < 128) { s = p.in[2]; d = (u16*)(p.ws + OFF_CK0); }
      else if (t4 < 256) { s = p.in[7]; d = (u16*)(p.ws + OFF_CK3); t4 -= 128; }
      else { s = p.in[4]; d = (u16*)(p.ws + OFF_CK1); t4 -= 256; }
      const size_t base = (size_t)t4 * 4096 + tid * 16;
#pragma unroll
      for (int i = 0; i < 2; ++i) {
        const float4 a = ntload4(s + base + i * 8), b4 = ntload4(s + base + i * 8 + 4);
        uint4 o; o.x = pack2(a.x, a.y); o.y = pack2(a.z, a.w); o.z = pack2(b4.x, b4.y); o.w = pack2(b4.z, b4.w);
        *reinterpret_cast<uint4*>(d + base + i * 8) = o;
      }
    } else {
      float2* rope = (float2*)(p.ws + OFF_ROPE);
      for (int i = tid; i < 1024; i += 256) {
        int pos = i >> 4, f = i & 15;
        float inv = powf(10000.0f, -(float)f / 16.0f);
        float ang = (float)pos * inv;
        rope[i] = make_float2(cosf(ang), sinf(ang));
      }
      if (tid == 0) {
        float d1 = 0.f, d2 = 0.f;
        for (int i = 0; i < 64; ++i) { d1 += p.in[22][i] * p.in[23][i]; d2 += p.in[24][i] * p.in[25][i]; }
        float lam_init = 0.8f - 0.6f * expf(-0.3f);
        float* LAM = (float*)(p.ws + OFF_LAM);
        LAM[0] = expf(d1) - expf(d2) + lam_init;
        LAM[1] = lam_init;
        LAM[2] = 0.f;
      }
      {
        float4* ssz = (float4*)(p.ws + OFF_SS);
        for (int i = tid; i < 8192; i += 256) ssz[i] = make_float4(0.f, 0.f, 0.f, 0.f);
      }
    }
  }
}

DI void sw_tasks(const Params& p) {
  const int lane = threadIdx.x & 63, w = threadIdx.x >> 6;
  const float* MOD = (const float*)(p.ws + OFF_MOD);
  float* SW = (float*)(p.ws + OFF_SW);
  for (int task = blockIdx.x * 4 + w; task < 1348; task += gridDim.x * 4) {
    int l, t8; const u16* WT;
    if (task < 512) { l = 1; t8 = task; WT = (const u16*)(p.ws + OFF_WTIN + WTIN_L1); }
    else if (task < 1028) { l = 2; t8 = task - 512; WT = (const u16*)(p.ws + OFF_WTIN + WTIN_L2); }
    else { l = 3; t8 = task - 1028; WT = (const u16*)(p.ws + OFF_WTIN + WTIN_L3); }
    float sh[5][16];
#pragma unroll
    for (int c = 0; c < 5; ++c)
#pragma unroll
      for (int q4 = 0; q4 < 4; ++q4) {
        const float4 v = *reinterpret_cast<const float4*>(MOD + (size_t)(l * 5 + c) * 3072 + lane * 16 + q4 * 4);
        sh[c][q4 * 4] = v.x; sh[c][q4 * 4 + 1] = v.y; sh[c][q4 * 4 + 2] = v.z; sh[c][q4 * 4 + 3] = v.w;
      }
#pragma unroll 2
    for (int r = 0; r < 8; ++r) {
      const int n = t8 * 8 + r;
      const uint4 w0 = *reinterpret_cast<const uint4*>(WT + (size_t)n * 1024 + lane * 16);
      const uint4 w1 = *reinterpret_cast<const uint4*>(WT + (size_t)n * 1024 + lane * 16 + 8);
      float wf[16];
      wf[0] = bf2f((u16)(w0.x & 0xffff)); wf[1] = bf2f((u16)(w0.x >> 16)); wf[2] = bf2f((u16)(w0.y & 0xffff)); wf[3] = bf2f((u16)(w0.y >> 16));
      wf[4] = bf2f((u16)(w0.z & 0xffff)); wf[5] = bf2f((u16)(w0.z >> 16)); wf[6] = bf2f((u16)(w0.w & 0xffff)); wf[7] = bf2f((u16)(w0.w >> 16));
      wf[8] = bf2f((u16)(w1.x & 0xffff)); wf[9] = bf2f((u16)(w1.x >> 16)); wf[10] = bf2f((u16)(w1.y & 0xffff)); wf[11] = bf2f((u16)(w1.y >> 16));
      wf[12] = bf2f((u16)(w1.z & 0xffff)); wf[13] = bf2f((u16)(w1.z >> 16)); wf[14] = bf2f((u16)(w1.w & 0xffff)); wf[15] = bf2f((u16)(w1.w >> 16));
#pragma unroll
      for (int c = 0; c < 5; ++c) {
        float s = 0.f;
#pragma unroll
        for (int k = 0; k < 16; ++k) s += sh[c][k] * wf[k];
        s = wave_sum(s);
        if (lane == 0) SW[(size_t)(l * 5 + c) * 4224 + n] = s;
      }
    }
  }
}

DI void norm_phase(const Params& p, int layer) {
  const int lane = threadIdx.x & 63, w = threadIdx.x >> 6;
  float* X = (float*)(p.ws + OFF_X);
  u16* H = (u16*)(p.ws + OFF_H);
  const float* MOD = (const float*)(p.ws + OFF_MOD);
  const float* nw = (layer < 4) ? p.in[lbase(layer)] : p.in[42];
  for (int r = blockIdx.x * 4 + w; r < 8192; r += gridDim.x * 4) {
    const float* src = (layer == 0) ? (r < 4096 ? p.in[0] + (size_t)r * 1024 : p.in[1] + (size_t)(r - 4096) * 1024) : X + (size_t)r * 1024;
    float4 v[4];
    float ss = 0.f;
#pragma unroll
    for (int i = 0; i < 4; ++i) {
      v[i] = (layer == 4) ? ntload4(src + (i * 64 + lane) * 4) : *reinterpret_cast<const float4*>(src + (i * 64 + lane) * 4);
      ss += v[i].x * v[i].x + v[i].y * v[i].y + v[i].z * v[i].z + v[i].w * v[i].w;
    }
    ss = wave_sum(ss);
    const float rs = rsqrtf(ss * (1.f / 1024.f) + NORM_EPS);
    if (layer < 4) {
      const int cond = r < 4096 ? 0 : 1 + ((r - 4096) >> 10);
      const float* md = MOD + (size_t)(layer * 5 + cond) * 3072;
#pragma unroll
      for (int i = 0; i < 4; ++i) {
        const int n = (i * 64 + lane) * 4;
        float4 g = *reinterpret_cast<const float4*>(nw + n);
        float4 sh = *reinterpret_cast<const float4*>(md + n);
        float4 sc = *reinterpret_cast<const float4*>(md + 1024 + n);
        float h0 = v[i].x * rs * g.x * (1.f + sc.x) + sh.x;
        float h1 = v[i].y * rs * g.y * (1.f + sc.y) + sh.y;
        float h2 = v[i].z * rs * g.z * (1.f + sc.z) + sh.z;
        float h3 = v[i].w * rs * g.w * (1.f + sc.w) + sh.w;
        uint2 pk; pk.x = pack2(h0, h1); pk.y = pack2(h2, h3);
        *reinterpret_cast<uint2*>(H + (size_t)r * 1024 + n) = pk;
      }
    } else {
#pragma unroll
      for (int i = 0; i < 4; ++i) {
        const int n = (i * 64 + lane) * 4;
        float4 g = *reinterpret_cast<const float4*>(nw + n);
        float4 o; o.x = v[i].x * rs * g.x; o.y = v[i].y * rs * g.y; o.z = v[i].z * rs * g.z; o.w = v[i].w * rs * g.w;
        ntstore4(p.out + OUT_Y + (size_t)r * 1024 + n, o);
      }
    }
  }
}

struct EpiArgs {
  int kind;
  int ld;
  int rope_end;
  int k_beg, k_end, v_end, kw;
  float* outk; float* outv;
  int layer;
  int fused;
};

DI void gemm_phase(const Params& p, char* smem, const u16* __restrict__ A, const u16* __restrict__ WT, int ntn, const EpiArgs e) {
  u16* As = (u16*)smem;
  u16* Bs = As + 2 * 128 * 64;
  const int tid = threadIdx.x, lane = tid & 63, w = tid >> 6, wm = w >> 1, wn = w & 1, l16 = lane & 15, quad = lane >> 4;
  const int ntiles = 64 * ntn;
  u16* PR = (u16*)(p.ws + OFF_PR);
  const int xg = blockIdx.x & 7, xl = blockIdx.x >> 3, xn = gridDim.x >> 3;
  (void)ntiles;
  for (int t = xl; t < 8 * ntn; t += xn) {
    const int tm = xg * 8 + (t & 7), tn = t >> 3;
    const int m0 = tm * 128, n0 = tn * 128;
    f32x4 acc[4][4];
#pragma unroll
    for (int i = 0; i < 4; ++i)
#pragma unroll
      for (int j = 0; j < 4; ++j) acc[i][j] = zero4();
    const u16* Ag = A + (size_t)m0 * 1024;
    const u16* Bg = WT + (size_t)n0 * 1024;
    const int lrow = tid >> 3, lkc = tid & 7;
    const char* Abase = (const char*)A;
    const char* Bbase = (const char*)WT;
    const unsigned aoff = (unsigned)((m0 + lrow) * 1024 + lkc * 8) * 2u;
    const unsigned boff = (unsigned)((n0 + lrow) * 1024 + lkc * 8) * 2u;
    u16* Ast = As + lrow * 64 + ((lkc ^ (lrow & 7)) * 8);
    u16* Bst = Bs + lrow * 64 + ((lkc ^ (lrow & 7)) * 8);
#define G_LD1(base_, off_) (*reinterpret_cast<const uint4*>((base_) + (off_)))
#define G_LOAD(S, kt_) \
    S##a0 = G_LD1(Abase, aoff + (unsigned)(kt_) * 128u); S##a1 = G_LD1(Abase, aoff + 65536u + (unsigned)(kt_) * 128u); \
    S##a2 = G_LD1(Abase, aoff + 131072u + (unsigned)(kt_) * 128u); S##a3 = G_LD1(Abase, aoff + 196608u + (unsigned)(kt_) * 128u); \
    S##b0 = G_LD1(Bbase, boff + (unsigned)(kt_) * 128u); S##b1 = G_LD1(Bbase, boff + 65536u + (unsigned)(kt_) * 128u); \
    S##b2 = G_LD1(Bbase, boff + 131072u + (unsigned)(kt_) * 128u); S##b3 = G_LD1(Bbase, boff + 196608u + (unsigned)(kt_) * 128u);
#define G_STORE(S, buf_) \
    *reinterpret_cast<uint4*>(Ast + (buf_) * 8192) = S##a0; *reinterpret_cast<uint4*>(Ast + (buf_) * 8192 + 32 * 64) = S##a1; \
    *reinterpret_cast<uint4*>(Ast + (buf_) * 8192 + 64 * 64) = S##a2; *reinterpret_cast<uint4*>(Ast + (buf_) * 8192 + 96 * 64) = S##a3; \
    *reinterpret_cast<uint4*>(Bst + (buf_) * 8192) = S##b0; *reinterpret_cast<uint4*>(Bst + (buf_) * 8192 + 32 * 64) = S##b1; \
    *reinterpret_cast<uint4*>(Bst + (buf_) * 8192 + 64 * 64) = S##b2; *reinterpret_cast<uint4*>(Bst + (buf_) * 8192 + 96 * 64) = S##b3;
#define G_COMPUTE(buf_) { \
      const u16* Ab = As + (buf_) * 8192 + (wm * 64 + l16) * 64; \
      const u16* Bb = Bs + (buf_) * 8192 + (wn * 64 + l16) * 64; \
      _Pragma("unroll") for (int ks = 0; ks < 2; ++ks) { \
        const int co = ((ks * 4 + quad) ^ (l16 & 7)) * 8; \
        bf16x8 af0 = ldf(Ab + co), af1 = ldf(Ab + 16 * 64 + co), af2 = ldf(Ab + 32 * 64 + co), af3 = ldf(Ab + 48 * 64 + co); \
        bf16x8 bf0 = ldf(Bb + co), bf1 = ldf(Bb + 16 * 64 + co), bf2 = ldf(Bb + 32 * 64 + co), bf3 = ldf(Bb + 48 * 64 + co); \
        acc[0][0] = mfma(bf0, af0, acc[0][0]); acc[0][1] = mfma(bf1, af0, acc[0][1]); acc[0][2] = mfma(bf2, af0, acc[0][2]); acc[0][3] = mfma(bf3, af0, acc[0][3]); \
        acc[1][0] = mfma(bf0, af1, acc[1][0]); acc[1][1] = mfma(bf1, af1, acc[1][1]); acc[1][2] = mfma(bf2, af1, acc[1][2]); acc[1][3] = mfma(bf3, af1, acc[1][3]); \
        acc[2][0] = mfma(bf0, af2, acc[2][0]); acc[2][1] = mfma(bf1, af2, acc[2][1]); acc[2][2] = mfma(bf2, af2, acc[2][2]); acc[2][3] = mfma(bf3, af2, acc[2][3]); \
        acc[3][0] = mfma(bf0, af3, acc[3][0]); acc[3][1] = mfma(bf1, af3, acc[3][1]); acc[3][2] = mfma(bf2, af3, acc[3][2]); acc[3][3] = mfma(bf3, af3, acc[3][3]); \
      } }
    uint4 Ra0, Ra1, Ra2, Ra3, Rb0, Rb1, Rb2, Rb3, Qa0, Qa1, Qa2, Qa3, Qb0, Qb1, Qb2, Qb3;
    G_LOAD(R, 0)
    G_LOAD(Q, 1)
    __syncthreads();
    G_STORE(R, 0)
    __syncthreads();
    for (int kt = 0; kt < 16; kt += 2) {
      const int k2 = kt + 2 < 16 ? kt + 2 : 14, k3 = kt + 3 < 16 ? kt + 3 : 15;
#define G_SCHED \
      __builtin_amdgcn_sched_group_barrier(0x100, 6, 0); \
      _Pragma("unroll") for (int sg_ = 0; sg_ < 2; ++sg_) { __builtin_amdgcn_sched_group_barrier(0x008, 1, 0); __builtin_amdgcn_sched_group_barrier(0x100, 1, 0); } \
      _Pragma("unroll") for (int sg_ = 0; sg_ < 8; ++sg_) { __builtin_amdgcn_sched_group_barrier(0x008, 2, 0); __builtin_amdgcn_sched_group_barrier(0x020, 1, 0); __builtin_amdgcn_sched_group_barrier(0x100, 1, 0); } \
      _Pragma("unroll") for (int sg_ = 0; sg_ < 7; ++sg_) { __builtin_amdgcn_sched_group_barrier(0x008, 2, 0); __builtin_amdgcn_sched_group_barrier(0x200, 1, 0); } \
      __builtin_amdgcn_sched_group_barrier(0x200, 1, 0);
      __builtin_amdgcn_sched_barrier(0);
      __builtin_amdgcn_s_setprio(1);
      G_LOAD(R, k2)
      G_COMPUTE(0)
      G_STORE(Q, 1)
      G_SCHED
      __builtin_amdgcn_sched_barrier(0);
      __builtin_amdgcn_s_setprio(0);
      __syncthreads();
      __builtin_amdgcn_s_setprio(1);
      G_LOAD(Q, k3)
      G_COMPUTE(1)
      G_STORE(R, 0)
      G_SCHED
      __builtin_amdgcn_sched_barrier(0);
      __builtin_amdgcn_s_setprio(0);
      __syncthreads();
#undef G_SCHED
    }
#undef G_LOAD
#undef G_LD1
#undef G_STORE
#undef G_COMPUTE
    const int nw = n0 + wn * 64;
    const int rbase = m0 + wm * 64 + l16;
    const int cq = quad * 4;
    if (e.kind <= 1 && e.fused) {
      const int cond = m0 < 4096 ? 0 : 1 + ((m0 - 4096) >> 10);
      const float* SS = (const float*)(p.ws + OFF_SS) + (size_t)e.layer * 8192;
      const float* SW = (const float*)(p.ws + OFF_SW) + (size_t)(e.layer * 5 + cond) * 4224 + nw + cq;
      float4 sw[4];
#pragma unroll
      for (int nb = 0; nb < 4; ++nb) sw[nb] = *reinterpret_cast<const float4*>(SW + nb * 16);
#pragma unroll
      for (int mb = 0; mb < 4; ++mb) {
        const float rs = rsqrtf(SS[rbase + mb * 16] * (1.f / 1024.f) + NORM_EPS);
#pragma unroll
        for (int nb = 0; nb < 4; ++nb) {
          acc[mb][nb][0] = rs * acc[mb][nb][0] + sw[nb].x; acc[mb][nb][1] = rs * acc[mb][nb][1] + sw[nb].y;
          acc[mb][nb][2] = rs * acc[mb][nb][2] + sw[nb].z; acc[mb][nb][3] = rs * acc[mb][nb][3] + sw[nb].w;
        }
      }
    }
    if (e.kind == 0) {
      const bool lat = m0 >= 4096;
      const bool do_rope = lat && nw < e.rope_end;
      const bool is_v = nw >= e.k_end && nw < e.v_end;
      const float2* rope = (const float2*)(p.ws + OFF_ROPE);
      if (!is_v) {
#pragma unroll
        for (int mb = 0; mb < 4; ++mb) {
          const int row = rbase + mb * 16;
          if (do_rope) {
            const int t = (row - 4096) & 1023;
            const float2* rr = rope + (t >> 6) * 16 + cq;
            const float2* rc = rope + (t & 63) * 16 + cq;
#pragma unroll
            for (int r = 0; r < 4; ++r) {
              const float2 cr = rr[r], cc = rc[r];
              const float v0 = acc[mb][0][r], v1 = acc[mb][1][r], v2 = acc[mb][2][r], v3 = acc[mb][3][r];
              acc[mb][0][r] = v0 * cr.x - v1 * cr.y; acc[mb][1][r] = v1 * cr.x + v0 * cr.y;
              acc[mb][2][r] = v2 * cc.x - v3 * cc.y; acc[mb][3][r] = v3 * cc.x + v2 * cc.y;
            }
          }
          u16* dst = PR + (size_t)row * e.ld + nw + cq;
#pragma unroll
          for (int nb = 0; nb < 4; ++nb) {
            uint2 pk; pk.x = pack2(acc[mb][nb][0], acc[mb][nb][1]); pk.y = pack2(acc[mb][nb][2], acc[mb][nb][3]);
            *reinterpret_cast<uint2*>(dst + nb * 16) = pk;
          }
        }
      } else {
        u16* Vst = (u16*)smem + w * (64 * 72);
#pragma unroll
        for (int mb = 0; mb < 4; ++mb)
#pragma unroll
          for (int nb = 0; nb < 4; ++nb)
#pragma unroll
            for (int r = 0; r < 4; ++r)
              Vst[(nb * 16 + cq + r) * 72 + (mb >> 1) * 32 + ((l16 >> 2) & 3) * 8 + (mb & 1) * 4 + (l16 & 3)] = f2bf(acc[mb][nb][r]);
        __builtin_amdgcn_fence(__ATOMIC_RELEASE, "wavefront");
        __builtin_amdgcn_s_waitcnt(0xc07f);
        __builtin_amdgcn_wave_barrier();
        u16* VT = (u16*)(p.ws + OFF_VT);
#pragma unroll
        for (int i = 0; i < 8; ++i) {
          const int c = lane + 64 * i, col = c >> 3, rc = c & 7;
          const uint4 v = *reinterpret_cast<const uint4*>(Vst + col * 72 + rc * 8);
          *reinterpret_cast<uint4*>(VT + (size_t)(nw - e.k_end + col) * 8192 + m0 + wm * 64 + rc * 8) = v;
        }
      }
      if (!lat && nw >= e.k_beg && nw < e.v_end) {
        float* ob = (nw < e.k_end) ? e.outk + (nw - e.k_beg) : e.outv + (nw - e.k_end);
#pragma unroll
        for (int mb = 0; mb < 4; ++mb) {
          float* o = ob + (size_t)(rbase + mb * 16) * e.kw + cq;
#pragma unroll
          for (int nb = 0; nb < 4; ++nb) {
            float4 v; v.x = acc[mb][nb][0]; v.y = acc[mb][nb][1]; v.z = acc[mb][nb][2]; v.w = acc[mb][nb][3];
            ntstore4(o + nb * 16, v);
          }
        }
      }
    } else if (e.kind == 1) {
      float* GATES = (float*)(p.ws + OFF_GATES);
#pragma unroll
      for (int mb = 0; mb < 4; ++mb) {
        const int row = rbase + mb * 16;
#pragma unroll
        for (int nb = 0; nb < 4; ++nb) {
          const int col = nw + nb * 16 + cq;
          if (col < 4096) {
            uint2 pk; pk.x = pack2(acc[mb][nb][0], acc[mb][nb][1]); pk.y = pack2(acc[mb][nb][2], acc[mb][nb][3]);
            *reinterpret_cast<uint2*>(PR + (size_t)row * 4224 + col) = pk;
          } else if (col < 4128) {
            float4 v; v.x = acc[mb][nb][0]; v.y = acc[mb][nb][1]; v.z = acc[mb][nb][2]; v.w = acc[mb][nb][3];
            *reinterpret_cast<float4*>(GATES + (size_t)row * 32 + (col - 4096)) = v;
          }
        }
      }
    } else {
      float* X = (float*)(p.ws + OFF_X);
      const float* MOD = (const float*)(p.ws + OFF_MOD);
      const int cond = m0 < 4096 ? 0 : 1 + ((m0 - 4096) >> 10);
      const float* gate = MOD + (size_t)(e.layer * 5 + cond) * 3072 + 2048;
      const float gsc = (e.kind == 3) ? ((const float*)(p.ws + OFF_LAM))[2] : 1.f;
      const float* nwn = p.in[lbase(e.layer < 3 ? e.layer + 1 : 3)];
      const float* scn = MOD + (size_t)((e.layer < 3 ? e.layer + 1 : 3) * 5 + cond) * 3072 + 1024;
      u16* HR = (u16*)(p.ws + OFF_HR);
      float ssp[4] = {0.f, 0.f, 0.f, 0.f};
#pragma unroll
      for (int nb = 0; nb < 4; ++nb) {
        const int col = nw + nb * 16 + cq;
        float4 g = *reinterpret_cast<const float4*>(gate + col);
        g.x *= gsc; g.y *= gsc; g.z *= gsc; g.w *= gsc;
        float4 gm = make_float4(0.f, 0.f, 0.f, 0.f);
        if (e.fused) {
          const float4 a = *reinterpret_cast<const float4*>(nwn + col), b = *reinterpret_cast<const float4*>(scn + col);
          gm.x = a.x * (1.f + b.x); gm.y = a.y * (1.f + b.y); gm.z = a.z * (1.f + b.z); gm.w = a.w * (1.f + b.w);
        }
#pragma unroll
        for (int mb = 0; mb < 4; ++mb) {
          const int xrow = rbase + mb * 16;
          float* xp = X + (size_t)xrow * 1024 + col;
          const float* xs = (e.layer == 0) ? (xrow < 4096 ? p.in[0] + (size_t)xrow * 1024 + col : p.in[1] + (size_t)(xrow - 4096) * 1024 + col) : xp;
          float4 x = *reinterpret_cast<const float4*>(xs);
          x.x += g.x * acc[mb][nb][0]; x.y += g.y * acc[mb][nb][1]; x.z += g.z * acc[mb][nb][2]; x.w += g.w * acc[mb][nb][3];
          *reinterpret_cast<float4*>(xp) = x;
          if (e.fused) {
            ssp[mb] += x.x * x.x + x.y * x.y + x.z * x.z + x.w * x.w;
            uint2 pk; pk.x = pack2(x.x * gm.x, x.y * gm.y); pk.y = pack2(x.z * gm.z, x.w * gm.w);
            *reinterpret_cast<uint2*>(HR + (size_t)(rbase + mb * 16) * 1024 + col) = pk;
          }
        }
      }
      if (e.fused) {
        float* SSn = (float*)(p.ws + OFF_SS) + (size_t)(e.layer + 1) * 8192;
#pragma unroll
        for (int mb = 0; mb < 4; ++mb) {
          float s = ssp[mb];
          s += __shfl_xor(s, 16); s += __shfl_xor(s, 32);
          if (quad == 0) atomicAdd(SSn + rbase + mb * 16, s);
        }
      }
    }
  }
}

struct AttnItem {
  const u16* kb; int ldk;
  const u16* vtb;
  const u16* kc; int ldkc;
  const u16* vtc;
  int t_lo, n_loc, n_cache, mask;
};

template <int KW, int NDV>
DI void attn_core(char* smem, const AttnItem& it, const bf16x8 (&qf)[2][2], int koff, int qi0,
                  f32x4 (&O)[NDV][2], float (&mrun)[2], float (&lrun)[2]) {
  constexpr int KLD = KW + 16;
  constexpr int NKC = KW / 32;
  constexpr int NVC = NDV / 2;
  u16* Ks = (u16*)smem;
  u16* Vt = Ks + 64 * KLD;
  const int tid = threadIdx.x, lane = tid & 63, l16 = lane & 15, quad = lane >> 4;
  const int ntile = it.n_loc + it.n_cache;
  const int krow = tid / (KW / 8), kdc = tid % (KW / 8);
  const int vrow = tid >> 3, vdc = tid & 7;
  constexpr int KRS = 2048 / KW;
  uint4 pk0, pk1, pk2, pk3, pv0, pv1, pv2, pv3;
  uint4 qk0, qk1, qk2, qk3, qv0, qv1, qv2, qv3;
  pk2 = pk3 = pv2 = pv3 = make_uint4(0u, 0u, 0u, 0u);
  qk0 = qk1 = qk2 = qk3 = qv0 = qv1 = qv2 = qv3 = make_uint4(0u, 0u, 0u, 0u);
  constexpr bool DIST2 = (NKC == 2);
  int ld_ = it.ldk, vld_ = 8192;
  const u16* kp_ = it.kb + (size_t)(it.t_lo * 64 + krow) * it.ldk + kdc * 8;
  const u16* vp_ = it.vtb + (size_t)vrow * 8192 + it.t_lo * 64 + vdc * 8;
#define A_GLOAD(S, t_) do { \
    if ((t_) == it.n_loc) { ld_ = it.ldkc; vld_ = 512; kp_ = it.kc + (size_t)krow * it.ldkc + kdc * 8; vp_ = it.vtc + (size_t)vrow * 512 + vdc * 8; } \
    S##k0 = *reinterpret_cast<const uint4*>(kp_); S##k1 = *reinterpret_cast<const uint4*>(kp_ + (size_t)KRS * ld_); \
    if (NKC > 2) { S##k2 = *reinterpret_cast<const uint4*>(kp_ + (size_t)2 * KRS * ld_); S##k3 = *reinterpret_cast<const uint4*>(kp_ + (size_t)3 * KRS * ld_); } \
    S##v0 = *reinterpret_cast<const uint4*>(vp_); S##v1 = *reinterpret_cast<const uint4*>(vp_ + (size_t)32 * vld_); \
    if (NVC > 2) { S##v2 = *reinterpret_cast<const uint4*>(vp_ + (size_t)64 * vld_); S##v3 = *reinterpret_cast<const uint4*>(vp_ + (size_t)96 * vld_); } \
    kp_ += (size_t)64 * ld_; vp_ += 64; \
  } while (0)
#define A_LSTORE(S, buf_) do { \
      u16* kd = Ks + (buf_) * BUFE + krow * KLD + kdc * 8; \
      *reinterpret_cast<uint4*>(kd) = S##k0; *reinterpret_cast<uint4*>(kd + KRS * KLD) = S##k1; \
      if (NKC > 2) { *reinterpret_cast<uint4*>(kd + 2 * KRS * KLD) = S##k2; *reinterpret_cast<uint4*>(kd + 3 * KRS * KLD) = S##k3; } \
      u16* vd = Vt + (buf_) * BUFE + vrow * 80 + vdc * 8; \
      *reinterpret_cast<uint4*>(vd) = S##v0; *reinterpret_cast<uint4*>(vd + 32 * 80) = S##v1; \
      if (NVC > 2) { *reinterpret_cast<uint4*>(vd + 64 * 80) = S##v2; *reinterpret_cast<uint4*>(vd + 96 * 80) = S##v3; } \
    } while (0)
  constexpr int BUFE = 64 * KLD + NDV * 16 * 80;
  constexpr float SC = 0.125f * 1.4426950408889634f;
  constexpr bool PAIR = DIST2;
  constexpr int NKB = PAIR ? 8 : 4;
  const int niter = PAIR ? (ntile + 1) / 2 : ntile;
  A_GLOAD(p, 0);
  if (PAIR) { if (ntile > 1) A_GLOAD(q, 1); }
  __syncthreads();
  A_LSTORE(p, 0);
  if (PAIR) { if (ntile > 1) A_LSTORE(q, 1); }
  __syncthreads();
  if (PAIR) { if (ntile > 2) A_GLOAD(p, 2); if (ntile > 3) A_GLOAD(q, 3); } else { if (ntile > 1) A_GLOAD(p, 1); }
  for (int itn = 0; itn < niter; ++itn) {
    const int t = PAIR ? 2 * itn : itn;
    const bool two = PAIR && (t + 1 < ntile);
    const u16* Kb0 = Ks + (PAIR ? 0 : (t & 1)) * BUFE;
    const u16* Vb0 = Vt + (PAIR ? 0 : (t & 1)) * BUFE;
    const u16* Kb1 = Ks + BUFE;
    const u16* Vb1 = Vt + BUFE;
    f32x4 S[2][NKB];
#pragma unroll
    for (int nq = 0; nq < 2; ++nq)
#pragma unroll
      for (int kb = 0; kb < NKB; ++kb) S[nq][kb] = zero4();
    __builtin_amdgcn_s_setprio(1);
#pragma unroll
    for (int kb = 0; kb < 4; ++kb)
#pragma unroll
      for (int ks = 0; ks < 2; ++ks) {
        const bf16x8 kf = ldf(Kb0 + (kb * 16 + l16) * KLD + koff + ks * 32 + quad * 8);
        S[0][kb] = mfma(kf, qf[0][ks], S[0][kb]);
        S[1][kb] = mfma(kf, qf[1][ks], S[1][kb]);
      }
    if (PAIR) {
      if (two) {
#pragma unroll
        for (int kb = 0; kb < 4; ++kb)
#pragma unroll
          for (int ks = 0; ks < 2; ++ks) {
            const bf16x8 kf = ldf(Kb1 + (kb * 16 + l16) * KLD + koff + ks * 32 + quad * 8);
            S[0][NKB - 4 + kb] = mfma(kf, qf[0][ks], S[0][NKB - 4 + kb]);
            S[1][NKB - 4 + kb] = mfma(kf, qf[1][ks], S[1][NKB - 4 + kb]);
          }
      } else {
#pragma unroll
        for (int kb = 0; kb < 4; ++kb) {
          f32x4 neg = {-1e30f, -1e30f, -1e30f, -1e30f};
          S[0][NKB - 4 + kb] = neg; S[1][NKB - 4 + kb] = neg;
        }
      }
    }
    __builtin_amdgcn_s_setprio(0);
    const bool mask0 = it.mask && (t < it.n_loc);
    const bool mask1 = PAIR && it.mask && (t + 1 < it.n_loc);
    const int key00 = (it.t_lo + t) * 64;
    bf16x8 P[2][NKB / 2];
#pragma unroll
    for (int nq = 0; nq < 2; ++nq) {
      float mx = -1e30f;
      const int qi = qi0 + nq * 16 + l16;
#pragma unroll
      for (int kb = 0; kb < NKB; ++kb)
#pragma unroll
        for (int j = 0; j < 4; ++j) {
          float v = S[nq][kb][j];
          if (kb < 4 ? mask0 : mask1) {
            const int d = (key00 + kb * 16 + quad * 4 + j) - qi;
            if (d > 128 || d < -128) v = -1e30f;
            S[nq][kb][j] = v;
          }
          mx = fmaxf(mx, v);
        }
      mx = fmaxf(mx, __shfl_xor(mx, 16));
      mx = fmaxf(mx, __shfl_xor(mx, 32));
      const float mnew = fmaxf(mrun[nq], mx);
      const float alpha = __builtin_amdgcn_exp2f((mrun[nq] - mnew) * SC);
      const float mb = -mnew * SC;
      mrun[nq] = mnew;
      float ls = 0.f;
#pragma unroll
      for (int kb = 0; kb < NKB; ++kb)
#pragma unroll
        for (int j = 0; j < 4; ++j) { const float pe = __builtin_amdgcn_exp2f(fmaf(S[nq][kb][j], SC, mb)); S[nq][kb][j] = pe; ls += pe; }
      lrun[nq] = lrun[nq] * alpha + ls;
#pragma unroll
      for (int dvb = 0; dvb < NDV; ++dvb) { O[dvb][nq][0] *= alpha; O[dvb][nq][1] *= alpha; O[dvb][nq][2] *= alpha; O[dvb][nq][3] *= alpha; }
#pragma unroll
      for (int ks = 0; ks < NKB / 2; ++ks) {
        uint4 u;
        u.x = pack2(S[nq][2 * ks][0], S[nq][2 * ks][1]); u.y = pack2(S[nq][2 * ks][2], S[nq][2 * ks][3]);
        u.z = pack2(S[nq][2 * ks + 1][0], S[nq][2 * ks + 1][1]); u.w = pack2(S[nq][2 * ks + 1][2], S[nq][2 * ks + 1][3]);
        P[nq][ks] = __builtin_bit_cast(bf16x8, u);
      }
    }
    if (!PAIR) {
      if (t + 1 < ntile) {
        A_LSTORE(p, (t + 1) & 1);
        if (t + 2 < ntile) A_GLOAD(p, t + 2);
      }
    }
    __builtin_amdgcn_s_setprio(1);
#pragma unroll
    for (int dvb = 0; dvb < NDV; ++dvb)
#pragma unroll
      for (int ks = 0; ks < 2; ++ks) {
        const bf16x8 vf = ldf(Vb0 + (dvb * 16 + l16) * 80 + ks * 32 + quad * 8);
        O[dvb][0] = mfma(vf, P[0][ks], O[dvb][0]);
        O[dvb][1] = mfma(vf, P[1][ks], O[dvb][1]);
      }
    if (PAIR) {
      if (two) {
#pragma unroll
        for (int dvb = 0; dvb < NDV; ++dvb)
#pragma unroll
          for (int ks = 0; ks < 2; ++ks) {
            const bf16x8 vf = ldf(Vb1 + (dvb * 16 + l16) * 80 + ks * 32 + quad * 8);
            O[dvb][0] = mfma(vf, P[0][NKB / 2 - 2 + ks], O[dvb][0]);
            O[dvb][1] = mfma(vf, P[1][NKB / 2 - 2 + ks], O[dvb][1]);
          }
      }
      __builtin_amdgcn_s_setprio(0);
      if (itn + 1 < niter) {
        __syncthreads();
        A_LSTORE(p, 0);
        if (t + 3 < ntile) A_LSTORE(q, 1);
        __syncthreads();
        if (t + 4 < ntile) A_GLOAD(p, t + 4);
        if (t + 5 < ntile) A_GLOAD(q, t + 5);
      }
    } else {
      __builtin_amdgcn_s_setprio(0);
      if (t + 1 < ntile) __syncthreads();
    }
  }
}
#undef A_LSTORE
#undef A_GLOAD
DI void attn_a_phase(const Params& p, char* smem, int layer) {
  const int tid = threadIdx.x, lane = tid & 63, w = tid >> 6, l16 = lane & 15, quad = lane >> 4;
  const u16* PR = (const u16*)(p.ws + OFF_PR);
  const u16* VT = (const u16*)(p.ws + OFF_VT);
  u16* OG = (u16*)(p.ws + OFF_H);
  const float* sink = p.in[lbase(layer) + 5];
  const u16* CK = (const u16*)(p.ws + (layer == 0 ? OFF_CK0 : OFF_CK3));
  const u16* CV = (const u16*)(p.ws + (layer == 0 ? OFF_CV0 : OFF_CV3));
  for (int itx0 = blockIdx.x; itx0 < 1024; itx0 += gridDim.x) {
    const bool lat = itx0 < 512;
    const int v0 = lat ? itx0 : itx0 - 512;
    const int itx = (v0 & 7) * 64 + (v0 >> 3);
    int qt, hkv, b, seq_row;
    AttnItem it;
    if (lat) {
      qt = itx & 31; hkv = (itx >> 5) & 3; b = itx >> 7; seq_row = 4096 + b * 1024;
      const int q0 = qt * 32;
      it.t_lo = (q0 >= 128 ? q0 - 128 : 0) >> 6;
      int t_hi = (q0 + 159) >> 6; if (t_hi > 15) t_hi = 15;
      it.n_loc = t_hi - it.t_lo + 1; it.mask = 1; it.n_cache = 8;
      it.kc = CK + (size_t)b * 512 * 256 + hkv * 64; it.ldkc = 256;
      it.vtc = CV + (size_t)(b * 256 + hkv * 64) * 512;
    } else {
      const int id = itx;
      qt = id & 7; hkv = (id >> 3) & 3; b = id >> 5; seq_row = b * 256;
      it.t_lo = 0; it.n_loc = 4; it.mask = 0; it.n_cache = 0; it.kc = nullptr; it.ldkc = 0; it.vtc = nullptr;
    }
    it.kb = PR + (size_t)seq_row * 2560 + 1024 + hkv * 64; it.ldk = 2560;
    it.vtb = VT + (size_t)(hkv * 64) * 8192 + seq_row;
    const int hq = hkv * 4 + w;
    bf16x8 qf[2][2];
#pragma unroll
    for (int nq = 0; nq < 2; ++nq) {
      const u16* qp = PR + (size_t)(seq_row + qt * 32 + nq * 16 + l16) * 2560 + hq * 64 + quad * 8;
      qf[nq][0] = ldf(qp); qf[nq][1] = ldf(qp + 32);
    }
    f32x4 O[4][2];
    float mrun[2], lrun[2];
    const float sk = sink[hq];
#pragma unroll
    for (int nq = 0; nq < 2; ++nq) { mrun[nq] = sk * 8.f; lrun[nq] = (quad == 0) ? 1.f : 0.f; }
#pragma unroll
    for (int d = 0; d < 4; ++d) { O[d][0] = zero4(); O[d][1] = zero4(); }
    attn_core<64, 4>(smem, it, qf, 0, qt * 32, O, mrun, lrun);
#pragma unroll
    for (int nq = 0; nq < 2; ++nq) {
      float l = lrun[nq]; l += __shfl_xor(l, 16); l += __shfl_xor(l, 32);
      const float inv = 1.f / l;
      const int row = seq_row + qt * 32 + nq * 16 + l16;
#pragma unroll
      for (int dvb = 0; dvb < 4; ++dvb) {
        const int col = hq * 64 + dvb * 16 + quad * 4;
        const uint2 zz = *reinterpret_cast<const uint2*>(PR + (size_t)row * 2560 + 1536 + col);
        const float z0 = bf2f((u16)(zz.x & 0xffff)), z1 = bf2f((u16)(zz.x >> 16)), z2 = bf2f((u16)(zz.y & 0xffff)), z3 = bf2f((u16)(zz.y >> 16));
        uint2 o;
        o.x = pack2(O[dvb][nq][0] * inv * silu(z0), O[dvb][nq][1] * inv * silu(z1));
        o.y = pack2(O[dvb][nq][2] * inv * silu(z2), O[dvb][nq][3] * inv * silu(z3));
        *reinterpret_cast<uint2*>(OG + (size_t)row * 1024 + col) = o;
      }
    }
  }
}

DI void attn_b_phase(const Params& p, char* smem) {
  const int tid = threadIdx.x, lane = tid & 63, w = tid >> 6, l16 = lane & 15, quad = lane >> 4;
  const int comp = w & 1, qh = w >> 1;
  const u16* PR = (const u16*)(p.ws + OFF_PR);
  const u16* VT = (const u16*)(p.ws + OFF_VT);
  u16* OG = (u16*)(p.ws + OFF_H);
  const float* LAM = (const float*)(p.ws + OFF_LAM);
  const float lam = LAM[0], lam_init = LAM[1];
  const float* subw = p.in[26];
  const u16* CK = (const u16*)(p.ws + OFF_CK1);
  const u16* CV = (const u16*)(p.ws + OFF_CV1);
  float4* Ox = (float4*)smem;
  for (int itx0 = blockIdx.x; itx0 < 1024; itx0 += gridDim.x) {
    const bool lat = itx0 < 512;
    const int v0 = lat ? itx0 : itx0 - 512;
    const int itx = (v0 & 7) * 64 + (v0 >> 3);
    int qt, h, b, seq_row;
    AttnItem it;
    if (lat) {
      qt = itx & 15; h = (itx >> 4) & 7; b = itx >> 7; seq_row = 4096 + b * 1024; it.n_loc = 16; it.n_cache = 8;
      it.kc = CK + (size_t)b * 512 * 1024 + h * 128; it.ldkc = 1024;
      it.vtc = CV + (size_t)(b * 1024 + h * 128) * 512;
    } else {
      const int id = itx; qt = id & 3; h = (id >> 2) & 7; b = id >> 5; seq_row = b * 256; it.n_loc = 4; it.n_cache = 0;
      it.kc = nullptr; it.ldkc = 0; it.vtc = nullptr;
    }
    it.t_lo = 0; it.mask = 0;
    it.kb = PR + (size_t)seq_row * 4096 + 1024 + h * 128; it.ldk = 4096;
    it.vtb = VT + (size_t)(h * 128) * 8192 + seq_row;
    bf16x8 qf[2][2];
#pragma unroll
    for (int nq = 0; nq < 2; ++nq) {
      const u16* qp = PR + (size_t)(seq_row + qt * 64 + qh * 32 + nq * 16 + l16) * 4096 + h * 128 + comp * 64 + quad * 8;
      qf[nq][0] = ldf(qp); qf[nq][1] = ldf(qp + 32);
    }
    f32x4 O[8][2];
    float mrun[2], lrun[2];
#pragma unroll
    for (int nq = 0; nq < 2; ++nq) { mrun[nq] = -1e30f; lrun[nq] = 0.f; }
#pragma unroll
    for (int d = 0; d < 8; ++d) { O[d][0] = zero4(); O[d][1] = zero4(); }
    attn_core<128, 8>(smem, it, qf, comp * 64, qt * 64 + qh * 32, O, mrun, lrun);
    float inv[2];
#pragma unroll
    for (int nq = 0; nq < 2; ++nq) { float l = lrun[nq]; l += __shfl_xor(l, 16); l += __shfl_xor(l, 32); inv[nq] = 1.f / l; }
    __syncthreads();
    if (comp == 1) {
#pragma unroll
      for (int d = 0; d < 8; ++d)
#pragma unroll
        for (int nq = 0; nq < 2; ++nq) {
          float4 v; v.x = O[d][nq][0] * inv[nq]; v.y = O[d][nq][1] * inv[nq]; v.z = O[d][nq][2] * inv[nq]; v.w = O[d][nq][3] * inv[nq];
          Ox[((qh * 8 + d) * 2 + nq) * 64 + lane] = v;
        }
    }
    __syncthreads();
    if (comp == 0) {
#pragma unroll
      for (int nq = 0; nq < 2; ++nq) {
        float ss = 0.f;
#pragma unroll
        for (int d = 0; d < 8; ++d) {
          const float4 o1 = Ox[((qh * 8 + d) * 2 + nq) * 64 + lane];
          const float d0 = O[d][nq][0] * inv[nq] - lam * o1.x, d1 = O[d][nq][1] * inv[nq] - lam * o1.y;
          const float d2 = O[d][nq][2] * inv[nq] - lam * o1.z, d3 = O[d][nq][3] * inv[nq] - lam * o1.w;
          O[d][nq][0] = d0; O[d][nq][1] = d1; O[d][nq][2] = d2; O[d][nq][3] = d3;
          ss += d0 * d0 + d1 * d1 + d2 * d2 + d3 * d3;
        }
        ss += __shfl_xor(ss, 16); ss += __shfl_xor(ss, 32);
        const float rs = rsqrtf(ss * (1.f / 128.f) + NORM_EPS) * (1.f - lam_init);
        const int row = seq_row + qt * 64 + qh * 32 + nq * 16 + l16;
#pragma unroll
        for (int d = 0; d < 8; ++d) {
          const int e0 = d * 16 + quad * 4;
          const int col = h * 128 + e0;
          const uint2 zz = *reinterpret_cast<const uint2*>(PR + (size_t)row * 4096 + 3072 + col);
          const float z0 = bf2f((u16)(zz.x & 0xffff)), z1 = bf2f((u16)(zz.x >> 16)), z2 = bf2f((u16)(zz.y & 0xffff)), z3 = bf2f((u16)(zz.y >> 16));
          const float4 sw = *reinterpret_cast<const float4*>(subw + e0);
          uint2 o;
          o.x = pack2(O[d][nq][0] * rs * sw.x * silu(z0), O[d][nq][1] * rs * sw.y * silu(z1));
          o.y = pack2(O[d][nq][2] * rs * sw.z * silu(z2), O[d][nq][3] * rs * sw.w * silu(z3));
          *reinterpret_cast<uint2*>(OG + (size_t)row * 1024 + col) = o;
        }
      }
    }
  }
}

DI void unpack8(const uint4 v, float (&f)[8]) {
  f[0] = bf2f((u16)(v.x & 0xffff)); f[1] = bf2f((u16)(v.x >> 16)); f[2] = bf2f((u16)(v.y & 0xffff)); f[3] = bf2f((u16)(v.y >> 16));
  f[4] = bf2f((u16)(v.z & 0xffff)); f[5] = bf2f((u16)(v.z >> 16)); f[6] = bf2f((u16)(v.w & 0xffff)); f[7] = bf2f((u16)(v.w >> 16));
}
DI void dn_conv_phase(const Params& p) {
  const int lane = threadIdx.x & 63, w = threadIdx.x >> 6, l16 = lane & 15, gsub = lane >> 4;
  const u16* PR = (const u16*)(p.ws + OFF_PR);
  const float* cw = p.in[32];
  const float* GATES = (const float*)(p.ws + OFF_GATES);
  float* GB = (float*)(p.ws + OFF_GB);
  constexpr int NCONV = 1024 * 6, NGATE = 512;
  for (int task = blockIdx.x * 4 + w; task < NCONV + NGATE; task += gridDim.x * 4) {
    if (task >= NCONV) {
      const int row0 = (task - NCONV) * 16;
      const u16* HR = (const u16*)(p.ws + OFF_HR);
      const u16* WG = (const u16*)(p.ws + OFF_WTIN + WTIN_L2) + (size_t)4096 * 1024;
      const int quad = lane >> 4;
      const u16* ap = HR + (size_t)(row0 + l16) * 1024 + quad * 8;
      const u16* bp0 = WG + (size_t)l16 * 1024 + quad * 8;
      const u16* bp1 = WG + (size_t)(16 + l16) * 1024 + quad * 8;
      f32x4 g0 = zero4(), g1 = zero4();
#pragma unroll 8
      for (int ks = 0; ks < 32; ++ks) {
        const bf16x8 a = ldf(ap + ks * 32), b0 = ldf(bp0 + ks * 32), b1 = ldf(bp1 + ks * 32);
        g0 = mfma(a, b0, g0);
        g1 = mfma(a, b1, g1);
      }
      const int cond = row0 < 4096 ? 0 : 1 + ((row0 - 4096) >> 10);
      const float* SS = (const float*)(p.ws + OFF_SS) + 2 * 8192;
      const float* SWg = (const float*)(p.ws + OFF_SW) + (size_t)(2 * 5 + cond) * 4224 + 4096;
      const float sw0 = SWg[l16], sw1 = SWg[16 + l16];
      const float dtb = p.in[34][l16], ea = expf(p.in[33][l16]);
#pragma unroll
      for (int r = 0; r < 4; ++r) {
        const int row = row0 + quad * 4 + r;
        const float rs = rsqrtf(SS[row] * (1.f / 1024.f) + NORM_EPS);
        const float raw_b = rs * g0[r] + sw0, raw_a = rs * g1[r] + sw1;
        GB[(size_t)row * 32 + l16] = 1.f / (1.f + expf(-raw_b));
        const float x = raw_a + dtb;
        const float sp = fmaxf(x, 0.f) + log1pf(expf(-fabsf(x)));
        GB[(size_t)row * 32 + 16 + l16] = -ea * sp;
      }
      continue;
    }
    const int strip = task / 6, g4 = task - strip * 6;
    const int g = g4 * 4 + gsub;
    const int r0 = strip * 8;
    int t0, L;
    if (r0 < 4096) { t0 = r0 & 255; L = 256; } else { t0 = (r0 - 4096) & 1023; L = 1024; }
    const int ch = g * 128 + l16 * 8;
    const u16* src = PR + (size_t)r0 * 4224 + ch;
    uint4 rows[10];
    const uint4 z4 = make_uint4(0u, 0u, 0u, 0u);
    rows[0] = (t0 > 0) ? ntload_u4(src - 4224) : z4;
#pragma unroll
    for (int i = 0; i < 8; ++i) rows[i + 1] = ntload_u4(src + (size_t)i * 4224);
    rows[9] = (t0 + 8 < L) ? ntload_u4(src + (size_t)8 * 4224) : z4;
    float w0[8], w1[8], w2[8];
#pragma unroll
    for (int k = 0; k < 2; ++k) {
      const float4 a = *reinterpret_cast<const float4*>(cw + ch + k * 4), b = *reinterpret_cast<const float4*>(cw + 3072 + ch + k * 4), c = *reinterpret_cast<const float4*>(cw + 6144 + ch + k * 4);
      w0[k * 4] = a.x; w0[k * 4 + 1] = a.y; w0[k * 4 + 2] = a.z; w0[k * 4 + 3] = a.w;
      w1[k * 4] = b.x; w1[k * 4 + 1] = b.y; w1[k * 4 + 2] = b.z; w1[k * 4 + 3] = b.w;
      w2[k * 4] = c.x; w2[k * 4 + 1] = c.y; w2[k * 4 + 2] = c.z; w2[k * 4 + 3] = c.w;
    }
    u16* dstb = (u16*)(p.ws + (g < 8 ? OFF_QN : (g < 16 ? OFF_KN : OFF_VV))) + (size_t)r0 * 1024 + (g & 7) * 128 + l16 * 8;
    float fm[8], f0[8], fp[8];
    unpack8(rows[0], fm); unpack8(rows[1], f0);
#pragma unroll
    for (int i = 0; i < 8; ++i) {
      unpack8(rows[i + 2], fp);
      float y[8];
      float ss = 0.f;
#pragma unroll
      for (int k = 0; k < 8; ++k) { y[k] = silu(w0[k] * fm[k] + w1[k] * f0[k] + w2[k] * fp[k]); ss += y[k] * y[k]; }
      if (g < 16) {
        ss = grp16_sum(ss);
        float sc = rsqrtf(ss + 1e-6f);
        if (g < 8) sc *= 0.08838834764831845f;
#pragma unroll
        for (int k = 0; k < 8; ++k) y[k] *= sc;
      }
      uint4 o; o.x = pack2(y[0], y[1]); o.y = pack2(y[2], y[3]); o.z = pack2(y[4], y[5]); o.w = pack2(y[6], y[7]);
      *reinterpret_cast<uint4*>(dstb + (size_t)i * 1024) = o;
#pragma unroll
      for (int k = 0; k < 8; ++k) { fm[k] = f0[k]; f0[k] = fp[k]; }
    }
  }
}

struct SeqInfo { int base_row, L, nc, gc_base; };
DI SeqInfo seq_info(int seq) {
  SeqInfo s;
  if (seq < 16) { s.base_row = seq * 256; s.L = 256; s.nc = 4; s.gc_base = seq * 4; }
  else { s.base_row = 4096 + (seq - 16) * 1024; s.L = 1024; s.nc = 16; s.gc_base = 64 + (seq - 16) * 16; }
  return s;
}

DI void dn_chunk_phase(const Params& p, char* smem) {
  const int lane = threadIdx.x & 63, w = threadIdx.x >> 6, l16 = lane & 15, quad = lane >> 4;
  float* Lw = (float*)smem + w * (64 * 68);
  const u16* KN = (const u16*)(p.ws + OFF_KN);
  const float* GB = (const float*)(p.ws + OFF_GB);
  u16* TM = (u16*)(p.ws + OFF_TM);
  for (int tk = blockIdx.x * 4 + w; tk < 2048; tk += gridDim.x * 4) {
    const int dir = tk & 1, h = (tk >> 1) & 7, gc = tk >> 4;
    int base_row, L, c;
    if (gc < 64) { base_row = (gc >> 2) * 256; L = 256; c = gc & 3; }
    else { const int lc = gc - 64; base_row = 4096 + (lc >> 4) * 1024; L = 1024; c = lc & 15; }
    const int p0 = c * 64;
    const int tok_i = base_row + (dir ? (L - 1 - (p0 + lane)) : (p0 + lane));
    const float beta_i = GB[(size_t)tok_i * 32 + dir * 8 + h];
    float gcum = GB[(size_t)tok_i * 32 + 16 + dir * 8 + h];
#pragma unroll
    for (int o = 1; o < 64; o <<= 1) { float t = __shfl_up(gcum, o); if (lane >= o) gcum += t; }
    bf16x8 f[4][4];
#pragma unroll
    for (int mb = 0; mb < 4; ++mb) {
      const int pi = p0 + mb * 16 + l16;
      const int tok = base_row + (dir ? (L - 1 - pi) : pi);
#pragma unroll
      for (int ks = 0; ks < 4; ++ks) f[mb][ks] = ldf(KN + (size_t)tok * 1024 + h * 128 + ks * 32 + quad * 8);
    }
#pragma unroll
    for (int mb = 0; mb < 4; ++mb)
#pragma unroll
      for (int nb = 0; nb <= mb; ++nb) {
        f32x4 a = zero4();
#pragma unroll
        for (int ks = 0; ks < 4; ++ks) a = mfma(f[mb][ks], f[nb][ks], a);
        const int jj = nb * 16 + l16;
        const float gj = __shfl(gcum, jj);
#pragma unroll
        for (int j = 0; j < 4; ++j) {
          const int i = mb * 16 + quad * 4 + j;
          const float gi = __shfl(gcum, i), bi = __shfl(beta_i, i);
          Lw[i * 68 + jj] = (i > jj) ? bi * a[j] * __expf(gi - gj) : 0.f;
        }
      }
    __builtin_amdgcn_fence(__ATOMIC_RELEASE, "wavefront");
    __builtin_amdgcn_s_waitcnt(0xc07f);
    __builtin_amdgcn_wave_barrier();
    float t[64];
    u16* Tout = TM + (size_t)((dir * 8 + h) * 128 + gc) * 4096;
#pragma unroll
    for (int i = 0; i < 64; ++i) {
      float a = (i == lane) ? 1.f : 0.f;
#pragma unroll
      for (int j4 = 0; j4 < (i + 3) / 4; ++j4) {
        const float4 lv = *reinterpret_cast<const float4*>(Lw + i * 68 + j4 * 4);
        if (j4 * 4 + 0 < i) a -= lv.x * t[j4 * 4 + 0];
        if (j4 * 4 + 1 < i) a -= lv.y * t[j4 * 4 + 1];
        if (j4 * 4 + 2 < i) a -= lv.z * t[j4 * 4 + 2];
        if (j4 * 4 + 3 < i) a -= lv.w * t[j4 * 4 + 3];
      }
      t[i] = a;
      Tout[i * 64 + lane] = f2bf(a);
    }
    __builtin_amdgcn_wave_barrier();
  }
}

DI void dn_scan_task(const Params& p, char* smem, int seq, int h, int dir, int slice) {
  const int tid = threadIdx.x, lane = tid & 63, w = tid >> 6, l16 = lane & 15, quad = lane >> 4;
  u16* Ks = (u16*)smem;
  u16* Sb = Ks + 2 * 64 * 136;
  u16* Rt = Sb + 32 * 136;
  u16* Vn = Rt + 32 * 80;
  u16* Vs = Vn + 32 * 80;
  u16* Pl = Vs + 32 * 80;
  float* sg = (float*)(Pl + 64 * 80);
  float* sbt = sg + 128;
  const u16* QN = (const u16*)(p.ws + OFF_QN);
  const u16* KN = (const u16*)(p.ws + OFF_KN);
  const u16* VV = (const u16*)(p.ws + OFF_VV);
  const float* GB = (const float*)(p.ws + OFF_GB);
  const u16* TM = (const u16*)(p.ws + OFF_TM);
  u16* OFB = (u16*)(p.ws + OFF_OFB) + (size_t)dir * 8192 * 1024;
  const SeqInfo si = seq_info(seq);
  f32x4 Sacc[2][2];
  if (seq >= 16) {
    const float* s0 = p.in[6] + (size_t)(((seq - 16) * 2 + dir) * 8 + h) * 16384;
#pragma unroll
    for (int mb2 = 0; mb2 < 2; ++mb2)
#pragma unroll
      for (int nb = 0; nb < 2; ++nb)
#pragma unroll
        for (int j = 0; j < 4; ++j) Sacc[mb2][nb][j] = s0[(size_t)(32 * w + mb2 * 16 + quad * 4 + j) * 128 + slice * 32 + nb * 16 + l16];
  } else {
#pragma unroll
    for (int mb2 = 0; mb2 < 2; ++mb2)
#pragma unroll
      for (int nb = 0; nb < 2; ++nb) Sacc[mb2][nb] = zero4();
  }
  __syncthreads();
#pragma unroll
  for (int mb2 = 0; mb2 < 2; ++mb2)
#pragma unroll
    for (int nb = 0; nb < 2; ++nb) {
      uint2 pk; pk.x = pack2(Sacc[mb2][nb][0], Sacc[mb2][nb][1]); pk.y = pack2(Sacc[mb2][nb][2], Sacc[mb2][nb][3]);
      *reinterpret_cast<uint2*>(Sb + (nb * 16 + l16) * 136 + 32 * w + mb2 * 16 + quad * 4) = pk;
    }
  uint4 nk0, nk1, nk2, nk3; float ngr = 0.f, nbe = 0.f; bf16x8 nq0, nq1, nq2, nq3, nt0, nt1; u16 nv[2][4];
  const int krow = lane, kdc0 = 4 * w;
#define SCAN_TOK(pi_) (si.base_row + (dir ? (si.L - 1 - (pi_)) : (pi_)))
#define SCAN_FETCH(c_) do { \
    const int q0_ = (c_) * 64; \
    { const u16* kp_ = KN + (size_t)SCAN_TOK(q0_ + krow) * 1024 + h * 128 + kdc0 * 8; \
      nk0 = *reinterpret_cast<const uint4*>(kp_); nk1 = *reinterpret_cast<const uint4*>(kp_ + 8); \
      nk2 = *reinterpret_cast<const uint4*>(kp_ + 16); nk3 = *reinterpret_cast<const uint4*>(kp_ + 24); } \
    if (w == 0) { const int tk_ = SCAN_TOK(q0_ + lane); ngr = GB[(size_t)tk_ * 32 + 16 + dir * 8 + h]; nbe = GB[(size_t)tk_ * 32 + dir * 8 + h]; } \
    { const u16* qp_ = QN + (size_t)SCAN_TOK(q0_ + 16 * w + l16) * 1024 + h * 128 + quad * 8; \
      nq0 = ldf(qp_); nq1 = ldf(qp_ + 32); nq2 = ldf(qp_ + 64); nq3 = ldf(qp_ + 96); } \
    { const u16* tp_ = TM + (size_t)((dir * 8 + h) * 128 + si.gc_base + (c_)) * 4096 + (16 * w + l16) * 64 + quad * 8; \
      nt0 = ldf(tp_); nt1 = ldf(tp_ + 32); } \
    _Pragma("unroll") for (int j = 0; j < 4; ++j) { \
      const u16* vp_ = VV + (size_t)SCAN_TOK(q0_ + 16 * w + quad * 4 + j) * 1024 + h * 128 + slice * 32 + l16; \
      nv[0][j] = vp_[0]; nv[1][j] = vp_[16]; } \
  } while (0)
#define SCAN_KST(v_, i_, b_) do { \
    *reinterpret_cast<uint4*>(Ks + (b_) * 8704 + krow * 136 + (kdc0 + (i_)) * 8) = v_; \
  } while (0)
#define SCAN_STAGE(b_) do { \
    SCAN_KST(nk0, 0, b_); SCAN_KST(nk1, 1, b_); SCAN_KST(nk2, 2, b_); SCAN_KST(nk3, 3, b_); \
    if (w == 0) { \
      float gcum_ = ngr; \
      _Pragma("unroll") for (int o = 1; o < 64; o <<= 1) { float t_ = __shfl_up(gcum_, o); if (lane >= o) gcum_ += t_; } \
      sg[(b_) * 64 + lane] = gcum_; \
      sbt[(b_) * 64 + lane] = nbe; \
    } \
  } while (0)
  SCAN_FETCH(0);
  SCAN_STAGE(0);
  for (int c = 0; c < si.nc; ++c) {
    __syncthreads();
    const int p0 = c * 64;
    const u16* Kc = Ks + (c & 1) * 8704;
    const float* sgc = sg + (c & 1) * 64;
    const float* sbc = sbt + (c & 1) * 64;
    bf16x8 qf[4], tf[2];
    qf[0] = nq0; qf[1] = nq1; qf[2] = nq2; qf[3] = nq3; tf[0] = nt0; tf[1] = nt1;
    float vv[2][4];
#pragma unroll
    for (int j = 0; j < 4; ++j) { vv[0][j] = bf2f(nv[0][j]); vv[1][j] = bf2f(nv[1][j]); }
    if (c + 1 < si.nc) SCAN_FETCH(c + 1);
    f32x4 QS[2], KS[2];
#pragma unroll
    for (int nb = 0; nb < 2; ++nb) { QS[nb] = zero4(); KS[nb] = zero4(); }
#pragma unroll
    for (int ks = 0; ks < 4; ++ks) {
      const bf16x8 kfr = ldf(Kc + (16 * w + l16) * 136 + ks * 32 + quad * 8);
#pragma unroll
      for (int nb = 0; nb < 2; ++nb) {
        bf16x8 sf = ldf(Sb + (nb * 16 + l16) * 136 + ks * 32 + quad * 8);
        QS[nb] = mfma(qf[ks], sf, QS[nb]);
        KS[nb] = mfma(kfr, sf, KS[nb]);
      }
    }
    float gi[4], bi[4], egi[4];
    const float glast = sgc[63];
#pragma unroll
    for (int j = 0; j < 4; ++j) { gi[j] = sgc[16 * w + quad * 4 + j]; bi[j] = sbc[16 * w + quad * 4 + j]; egi[j] = __expf(gi[j]); }
#pragma unroll
    for (int nb = 0; nb < 2; ++nb) {
      float r0 = bi[0] * (vv[nb][0] - egi[0] * KS[nb][0]);
      float r1 = bi[1] * (vv[nb][1] - egi[1] * KS[nb][1]);
      float r2 = bi[2] * (vv[nb][2] - egi[2] * KS[nb][2]);
      float r3 = bi[3] * (vv[nb][3] - egi[3] * KS[nb][3]);
      uint2 pk; pk.x = pack2(r0, r1); pk.y = pack2(r2, r3);
      *reinterpret_cast<uint2*>(Rt + (nb * 16 + l16) * 80 + 16 * w + quad * 4) = pk;
    }
    bf16x8 Pf[2];
    {
      const int icol = 16 * w + l16;
      const float gic = sgc[icol];
      f32x4 pt[4];
#pragma unroll
      for (int nb4 = 0; nb4 < 4; ++nb4) {
        pt[nb4] = zero4();
        if (nb4 <= w) {
#pragma unroll
          for (int ks = 0; ks < 4; ++ks) pt[nb4] = mfma(ldf(Kc + (nb4 * 16 + l16) * 136 + ks * 32 + quad * 8), qf[ks], pt[nb4]);
        }
        const float4 gj4 = *reinterpret_cast<const float4*>(sgc + nb4 * 16 + quad * 4);
        const int jj0 = nb4 * 16 + quad * 4;
        pt[nb4][0] = (nb4 <= w && icol >= jj0 + 0) ? pt[nb4][0] * __expf(gic - gj4.x) : 0.f;
        pt[nb4][1] = (nb4 <= w && icol >= jj0 + 1) ? pt[nb4][1] * __expf(gic - gj4.y) : 0.f;
        pt[nb4][2] = (nb4 <= w && icol >= jj0 + 2) ? pt[nb4][2] * __expf(gic - gj4.z) : 0.f;
        pt[nb4][3] = (nb4 <= w && icol >= jj0 + 3) ? pt[nb4][3] * __expf(gic - gj4.w) : 0.f;
      }
#pragma unroll
      for (int k2 = 0; k2 < 2; ++k2) {
        uint4 u;
        u.x = pack2(pt[2 * k2][0], pt[2 * k2][1]); u.y = pack2(pt[2 * k2][2], pt[2 * k2][3]);
        u.z = pack2(pt[2 * k2 + 1][0], pt[2 * k2 + 1][1]); u.w = pack2(pt[2 * k2 + 1][2], pt[2 * k2 + 1][3]);
        Pf[k2] = __builtin_bit_cast(bf16x8, u);
      }
    }
    __syncthreads();
    f32x4 VN[2];
#pragma unroll
    for (int nb = 0; nb < 2; ++nb) {
      VN[nb] = zero4();
#pragma unroll
      for (int k2 = 0; k2 < 2; ++k2) VN[nb] = mfma(tf[k2], ldf(Rt + (nb * 16 + l16) * 80 + k2 * 32 + quad * 8), VN[nb]);
      uint2 pk, ps;
      pk.x = pack2(VN[nb][0], VN[nb][1]); pk.y = pack2(VN[nb][2], VN[nb][3]);
      ps.x = pack2(VN[nb][0] * __expf(glast - gi[0]), VN[nb][1] * __expf(glast - gi[1]));
      ps.y = pack2(VN[nb][2] * __expf(glast - gi[2]), VN[nb][3] * __expf(glast - gi[3]));
      *reinterpret_cast<uint2*>(Vn + (nb * 16 + l16) * 80 + (w >> 1) * 32 + quad * 8 + (w & 1) * 4) = pk;
      *reinterpret_cast<uint2*>(Vs + (nb * 16 + l16) * 80 + 16 * w + quad * 4) = ps;
    }
    __syncthreads();
#pragma unroll
    for (int nb = 0; nb < 2; ++nb) {
      f32x4 oi = zero4();
#pragma unroll
      for (int k2 = 0; k2 < 2; ++k2)
        oi = mfma(Pf[k2], ldf(Vn + (nb * 16 + l16) * 80 + k2 * 32 + quad * 8), oi);
#pragma unroll
      for (int j = 0; j < 4; ++j) {
        const int pi = p0 + 16 * w + quad * 4 + j;
        const int tok = si.base_row + (dir ? (si.L - 1 - pi) : pi);
        OFB[(size_t)tok * 1024 + h * 128 + slice * 32 + nb * 16 + l16] = f2bf(egi[j] * QS[nb][j] + oi[j]);
      }
    }
    const float eg = __expf(glast);
    bf16x8 ktf[2][2];
    {
      typedef short s16x4_t __attribute__((ext_vector_type(4)));
      const unsigned kta = (unsigned)(size_t)(Kc + (quad * 8 + (l16 >> 2)) * 136 + 32 * w + 4 * (l16 & 3));
      s16x4_t t00l, t00h, t01l, t01h, t10l, t10h, t11l, t11h;
      asm volatile(
          "ds_read_b64_tr_b16 %0, %8\n\t"
          "ds_read_b64_tr_b16 %1, %8 offset:1088\n\t"
          "ds_read_b64_tr_b16 %2, %8 offset:8704\n\t"
          "ds_read_b64_tr_b16 %3, %8 offset:9792\n\t"
          "ds_read_b64_tr_b16 %4, %8 offset:32\n\t"
          "ds_read_b64_tr_b16 %5, %8 offset:1120\n\t"
          "ds_read_b64_tr_b16 %6, %8 offset:8736\n\t"
          "ds_read_b64_tr_b16 %7, %8 offset:9824\n\t"
          "s_waitcnt lgkmcnt(0)"
          : "=&v"(t00l), "=&v"(t00h), "=&v"(t01l), "=&v"(t01h), "=&v"(t10l), "=&v"(t10h), "=&v"(t11l), "=&v"(t11h)
          : "v"(kta) : "memory");
      ktf[0][0] = __builtin_shufflevector(t00l, t00h, 0, 1, 2, 3, 4, 5, 6, 7);
      ktf[0][1] = __builtin_shufflevector(t01l, t01h, 0, 1, 2, 3, 4, 5, 6, 7);
      ktf[1][0] = __builtin_shufflevector(t10l, t10h, 0, 1, 2, 3, 4, 5, 6, 7);
      ktf[1][1] = __builtin_shufflevector(t11l, t11h, 0, 1, 2, 3, 4, 5, 6, 7);
    }
#pragma unroll
    for (int mb2 = 0; mb2 < 2; ++mb2)
#pragma unroll
      for (int nb = 0; nb < 2; ++nb) {
        f32x4 a = Sacc[mb2][nb];
        a[0] *= eg; a[1] *= eg; a[2] *= eg; a[3] *= eg;
#pragma unroll
        for (int k2 = 0; k2 < 2; ++k2)
          a = mfma(ktf[mb2][k2], ldf(Vs + (nb * 16 + l16) * 80 + k2 * 32 + quad * 8), a);
        Sacc[mb2][nb] = a;
        uint2 pk; pk.x = pack2(a[0], a[1]); pk.y = pack2(a[2], a[3]);
        *reinterpret_cast<uint2*>(Sb + (nb * 16 + l16) * 136 + 32 * w + mb2 * 16 + quad * 4) = pk;
      }
    if (c + 1 < si.nc) SCAN_STAGE((c + 1) & 1);
  }
  if (seq < 16) {
    float* so = p.out + OUT_L2S + (size_t)((seq * 2 + dir) * 8 + h) * 16384;
#pragma unroll
    for (int mb2 = 0; mb2 < 2; ++mb2)
#pragma unroll
      for (int nb = 0; nb < 2; ++nb)
#pragma unroll
        for (int j = 0; j < 4; ++j) __builtin_nontemporal_store(Sacc[mb2][nb][j], so + (size_t)(32 * w + mb2 * 16 + quad * 4 + j) * 128 + slice * 32 + nb * 16 + l16);
  }
}

#undef SCAN_TOK
#undef SCAN_FETCH
#undef SCAN_KST
#undef SCAN_STAGE
DI void dn_scan_phase(const Params& p, char* smem) {
  for (int unit = blockIdx.x; unit < 512; unit += gridDim.x) {
    const int ntask = unit < 256 ? 1 : 4;
    for (int q = 0; q < ntask; ++q) {
      int seq, code;
      if (unit < 256) { const int u = (unit & 7) * 32 + (unit >> 3); seq = 16 + (u >> 6); code = u & 63; }
      else { const int u0 = unit - 256; const int u = (u0 & 7) * 32 + (u0 >> 3); const int ct = u * 4 + q; seq = ct >> 6; code = ct & 63; }
      dn_scan_task(p, smem, seq, (code >> 3) & 7, (code >> 2) & 1, code & 3);
    }
  }
}

DI void dn_out_phase(const Params& p) {
  const int lane = threadIdx.x & 63, w = threadIdx.x >> 6, l16 = lane & 15, hs = lane >> 4;
  const u16* OF = (const u16*)(p.ws + OFF_OFB);
  const u16* OB = OF + (size_t)8192 * 1024;
  const u16* PR = (const u16*)(p.ws + OFF_PR);
  u16* OG = (u16*)(p.ws + OFF_H);
  float gw[8];
  {
    const float4 a = *reinterpret_cast<const float4*>(p.in[35] + l16 * 8), b = *reinterpret_cast<const float4*>(p.in[35] + l16 * 8 + 4);
    gw[0] = a.x; gw[1] = a.y; gw[2] = a.z; gw[3] = a.w; gw[4] = b.x; gw[5] = b.y; gw[6] = b.z; gw[7] = b.w;
  }
  for (int task = blockIdx.x * 4 + w; task < 4096; task += gridDim.x * 4) {
    uint4 a[4], b[4], z[4];
#pragma unroll
    for (int u = 0; u < 4; ++u) {
      const int r = task * 2 + (u >> 1), h = (u & 1) * 4 + hs;
      const size_t off = (size_t)r * 1024 + h * 128 + l16 * 8;
      a[u] = ntload_u4(OF + off);
      b[u] = ntload_u4(OB + off);
      z[u] = ntload_u4(PR + (size_t)r * 4224 + 3072 + h * 128 + l16 * 8);
    }
#pragma unroll
    for (int u = 0; u < 4; ++u) {
      const int r = task * 2 + (u >> 1), h = (u & 1) * 4 + hs;
      float fa[8], fb[8], fz[8];
      unpack8(a[u], fa); unpack8(b[u], fb); unpack8(z[u], fz);
      float ss = 0.f;
#pragma unroll
      for (int k = 0; k < 8; ++k) { fa[k] += fb[k]; ss += fa[k] * fa[k]; }
      ss = grp16_sum(ss);
      const float rs = rsqrtf(ss * (1.f / 128.f) + NORM_EPS);
#pragma unroll
      for (int k = 0; k < 8; ++k) fa[k] = fa[k] * rs * gw[k] * silu(fz[k]);
      uint4 o; o.x = pack2(fa[0], fa[1]); o.y = pack2(fa[2], fa[3]); o.z = pack2(fa[4], fa[5]); o.w = pack2(fa[6], fa[7]);
      *reinterpret_cast<uint4*>(OG + (size_t)r * 1024 + h * 128 + l16 * 8) = o;
    }
  }
}

#define XB_TMO      128
#define XB_XCNT(j)  (256  + 64 * (j))
#define XB_XSUB(j)  (1280 + 64 * (j))
#define XB_XGEN(j)  (2304 + 64 * (j))
#define XB_TOP      3328
#define XB_TOPGEN   3392
#define XCD_BAR_WORDS 3456
#define XB_SPIN_CAP (1u << 20)
#define LAS __attribute__((address_space(3)))
DI unsigned xb_ld(unsigned* p)              { return __hip_atomic_load(p, __ATOMIC_RELAXED, __HIP_MEMORY_SCOPE_AGENT); }
DI unsigned xb_add(unsigned* p, unsigned v) { return __hip_atomic_fetch_add(p, v, __ATOMIC_RELAXED, __HIP_MEMORY_SCOPE_AGENT); }
DI unsigned xb_xcc_id() { return (unsigned)__builtin_amdgcn_s_getreg((3 << 11) | 20) & 0xFu; }
#define XB_SPIN(cond, bar) do { unsigned _sp = 0; while (cond) { __builtin_amdgcn_s_sleep(1); \
    if ((++_sp & 255u) == 0u) { if (xb_ld(&(bar)[XB_TMO])) break; if (_sp > XB_SPIN_CAP) { atomicAdd(&(bar)[XB_TMO], 1u); break; } } } } while (0)
struct XcdBarrier { unsigned* bar; unsigned x; volatile LAS unsigned* st; };
DI XcdBarrier xcd_barrier_post(unsigned* bar, volatile LAS unsigned* st) {
  XcdBarrier b; b.bar = bar; b.x = xb_xcc_id(); b.st = st;
  if (threadIdx.x == 0) (void)xb_add(&bar[XB_XCNT(b.x)], 1u);
  return b;
}
DI void xcd_barrier_complete(unsigned* bar, unsigned x, unsigned& nloc, unsigned& nx) {
  const unsigned G = gridDim.x * gridDim.y * gridDim.z;
  unsigned sum, cnt, mine, sp = 0u;
  for (;;) {
    sum = 0u; cnt = 0u; mine = 0u;
#pragma unroll
    for (unsigned j = 0; j < 16; ++j) { const unsigned c = xb_ld(&bar[XB_XCNT(j)]); sum += c; cnt += (c > 0u) ? 1u : 0u; mine = (j == x) ? c : mine; }
    if (sum == G) break;
    __builtin_amdgcn_s_sleep(1);
    if ((++sp & 255u) == 0u) { if (xb_ld(&bar[XB_TMO])) break; if (sp > XB_SPIN_CAP) { atomicAdd(&bar[XB_TMO], 1u); break; } }
  }
  nloc = mine > 0u ? mine : 1u; nx = cnt > 0u ? cnt : 1u;
}
DI void xcd_barrier(const XcdBarrier& b) {
  asm volatile("s_waitcnt vmcnt(0)" ::: "memory");
  __syncthreads();
  if (threadIdx.x == 0) {
    unsigned* bar = b.bar;
    __builtin_amdgcn_s_waitcnt(0);
    unsigned nloc = b.st[0], nx = b.st[1];
    if (nloc == 0u) { xcd_barrier_complete(bar, b.x, nloc, nx); b.st[0] = nloc; b.st[1] = nx; }
    const unsigned old = xb_add(&bar[XB_XSUB(b.x)], 1u);
    const unsigned gen = old / nloc;
    if (old + 1u == (gen + 1u) * nloc) {
      __builtin_amdgcn_fence(__ATOMIC_RELEASE, "agent");
      asm volatile("s_waitcnt vmcnt(0)" ::: "memory");
      const unsigned og = xb_add(&bar[XB_TOP], 1u);
      const unsigned tg = og / nx;
      if (og + 1u == (tg + 1u) * nx) xb_add(&bar[XB_TOPGEN], 1u);
      else XB_SPIN(xb_ld(&bar[XB_TOPGEN]) == tg, bar);
      __builtin_amdgcn_fence(__ATOMIC_ACQUIRE, "agent");
      xb_add(&bar[XB_XGEN(b.x)], 1u);
      asm volatile("s_waitcnt vmcnt(0)" ::: "memory");
    } else {
      XB_SPIN(xb_ld(&bar[XB_XGEN(b.x)]) == gen, bar);
      __builtin_amdgcn_fence(__ATOMIC_ACQUIRE, "agent");
      asm volatile("s_waitcnt vmcnt(0)" ::: "memory");
    }
  }
  __syncthreads();
}

DI void gemm_for(const Params& p, char* smem, int layer, int which) {
  const u16* H = (const u16*)(p.ws + OFF_H);
  EpiArgs e;
  const u16* WT;
  int ntn;
  e.layer = layer;
  if (which >= 1) {
    e.kind = which == 1 ? 2 : 3; e.ld = 0; e.rope_end = 0; e.k_beg = 0; e.k_end = 0; e.v_end = 0; e.kw = 0; e.outk = nullptr; e.outv = nullptr;
    WT = (const u16*)(p.ws + OFF_WTOUT + (size_t)layer * 2097152); ntn = 8;
  } else if (layer == 1) {
    e.kind = 0; e.ld = 4096; e.rope_end = 2048; e.k_beg = 1024; e.k_end = 2048; e.v_end = 3072; e.kw = 1024;
    e.outk = p.out + OUT_L1K; e.outv = p.out + OUT_L1V;
    WT = (const u16*)(p.ws + OFF_WTIN + WTIN_L1); ntn = 32;
  } else if (layer == 2) {
    e.kind = 1; e.ld = 4224; e.rope_end = 0; e.k_beg = 0; e.k_end = 0; e.v_end = 0; e.kw = 0; e.outk = nullptr; e.outv = nullptr;
    WT = (const u16*)(p.ws + OFF_WTIN + WTIN_L2); ntn = 32;
  } else {
    e.kind = 0; e.ld = 2560; e.rope_end = 1280; e.k_beg = 1024; e.k_end = 1280; e.v_end = 1536; e.kw = 256;
    e.outk = p.out + (layer == 0 ? OUT_L0K : OUT_L3K); e.outv = p.out + (layer == 0 ? OUT_L0V : OUT_L3V);
    WT = (const u16*)(p.ws + OFF_WTIN + (layer == 0 ? WTIN_L0 : WTIN_L3)); ntn = 20;
  }
  e.fused = (which == 0) ? (layer >= 1) : (which == 1 && layer < 3);
  const u16* A = (which == 0 && layer >= 1) ? (const u16*)(p.ws + OFF_HR) : H;
  gemm_phase(p, smem, A, WT, ntn, e);
}

constexpr int NPHASE = 30;
DI void run_phase(const Params& p, char* smem, int ph) {
  if (ph == 0) { phase0(p, smem); return; }
  if (ph == 29) { norm_phase(p, 4); return; }
  const int l = (ph - 1) / 7, s = (ph - 1) % 7;
  if (s == 0) norm_phase(p, l);
  else if (s == 1) gemm_for(p, smem, l, 0);
  else if (s == 6) gemm_for(p, smem, l, 1);
  else if (l == 2) {
    if (s == 2) dn_conv_phase(p);
    else if (s == 3) dn_chunk_phase(p, smem);
    else if (s == 4) dn_scan_phase(p, smem);
    else dn_out_phase(p);
  } else if (s == 2) {
    if (l == 1) attn_b_phase(p, smem); else attn_a_phase(p, smem, l);
  }
}
DI bool phase_empty(int ph) {
  if (ph == 0 || ph == 29) return false;
  const int l = (ph - 1) / 7, s = (ph - 1) % 7;
  return (l != 2) && (s >= 3 && s <= 5);
}

#if ONE_LAUNCH
__global__ void __launch_bounds__(256, 2) mega_kernel(Params p) {
  __shared__ __attribute__((aligned(16))) char smem[SMEM_BYTES];
  cg::grid_group grid = cg::this_grid();
  __shared__ uint4 xb_words;
  if (threadIdx.x == 0) xb_words = make_uint4(0u, 0u, 0u, 0u);
  __syncthreads();
  XcdBarrier xb = xcd_barrier_post((unsigned*)(p.ws + OFF_BAR), (volatile LAS unsigned*)&xb_words);
  if (p.ws == nullptr) grid.sync();
#define REP_0(x) x;
#define REP_1(x) x; x;
#define REP_I(n, x) REP_##n(x)
#define REP(n, x) REP_I(n, x)
#define GSYNC REP(DUP_SYNC, xcd_barrier(xb))
  REP(DUP_P0, phase0(p, smem)) GSYNC;
  REP(DUP_NORM, norm_phase(p, 0)) sw_tasks(p); GSYNC;
  REP(DUP_GEMM, gemm_for(p, smem, 0, 0)) GSYNC;
  REP(DUP_ATT, attn_a_phase(p, smem, 0)) GSYNC;
  gemm_for(p, smem, 0, 1);
#if DUP_OUT
  gemm_for(p, smem, 0, 2);
#endif
  GSYNC;
  REP(DUP_GEMM, gemm_for(p, smem, 1, 0)) GSYNC;
  REP(DUP_DN2, attn_b_phase(p, smem)) GSYNC;
  gemm_for(p, smem, 1, 1);
#if DUP_OUT
  gemm_for(p, smem, 1, 2);
#endif
  GSYNC;
  REP(DUP_GEMM, gemm_for(p, smem, 2, 0)) GSYNC;
  REP(DUP_DN, dn_conv_phase(p)) GSYNC;
  REP(DUP_DN, dn_chunk_phase(p, smem)) GSYNC;
  REP(DUP_DN, dn_scan_phase(p, smem)) GSYNC;
  REP(DUP_DN, dn_out_phase(p)) GSYNC;
  gemm_for(p, smem, 2, 1);
#if DUP_OUT
  gemm_for(p, smem, 2, 2);
#endif
  GSYNC;
  REP(DUP_GEMM, gemm_for(p, smem, 3, 0)) GSYNC;
  REP(DUP_ATT, attn_a_phase(p, smem, 3)) GSYNC;
  gemm_for(p, smem, 3, 1);
#if DUP_OUT
  gemm_for(p, smem, 3, 2);
#endif
  GSYNC;
  REP(DUP_NORM, norm_phase(p, 4))
}
#else
__global__ void __launch_bounds__(256, 2) phase_kernel(Params p, int ph) {
  __shared__ __attribute__((aligned(16))) char smem[SMEM_BYTES];
  run_phase(p, smem, ph);
}
#endif

extern "C" void kernel_launch(void* const* d_in, const int* in_sizes, int n_in, void* d_out, int out_size, void* d_ws, size_t ws_size,
                              hipStream_t stream) {
  if (n_in != 43 || ws_size < WS_END) { fprintf(stderr, "kernel_launch: unexpected n_in %d / ws_size %zu\n", n_in, ws_size); return; }
  Params p{};
  for (int i = 0; i < 43; ++i) p.in[i] = (const float*)d_in[i];
  p.out = (float*)d_out;
  p.ws = (char*)d_ws;
#if ONE_LAUNCH
  static int grid_blocks = 0;
  if (!grid_blocks) {
    int dev = 0, cus = 0, per_cu = 0;
    hipGetDevice(&dev);
    hipDeviceGetAttribute(&cus, hipDeviceAttributeMultiprocessorCount, dev);
    hipOccupancyMaxActiveBlocksPerMultiprocessor(&per_cu, mega_kernel, 256, 0);
    if (per_cu < 1) per_cu = 1;
    if (per_cu > 2) per_cu = 2;
    grid_blocks = cus * per_cu;
  }
  (void)hipMemsetAsync((char*)d_ws + OFF_BAR, 0, 16384, stream);
  void* args[] = {&p};
  hipError_t e = hipLaunchCooperativeKernel((void*)mega_kernel, dim3(grid_blocks), dim3(256), args, 0, stream);
  if (e != hipSuccess) fprintf(stderr, "cooperative launch failed: %s (grid %d)\n", hipGetErrorString(e), grid_blocks);
#else
  for (int ph = 0; ph < NPHASE; ++ph) { bool empty = (ph != 0 && ph != 29) && ((ph - 1) / 7 != 2) && ((ph - 1) % 7 >= 3 && (ph - 1) % 7 <= 5); if (!empty) phase_kernel<<<512, 256, 0, stream>>>(p, ph); }
#endif
}
```

```cpp
#include <hip/hip_runtime.h>
#include <hip/hip_bf16.h>
#include <hip/hip_cooperative_groups.h>
#include <cstdio>
namespace cg = cooperative_groups;

#define ONE_LAUNCH 1
#define DUP_P0 0
#define DUP_GEMM 0
#define DUP_ATT 0
#define DUP_DN 0
#define DUP_DN2 0
#define DUP_SYNC 0
#define DUP_NORM 0
#define DUP_OUT 0

typedef unsigned short u16;
using bf16x8 = __attribute__((ext_vector_type(8))) short;
using f32x4 = __attribute__((ext_vector_type(4))) float;
#define DI __device__ __forceinline__

constexpr size_t OFF_X    = 0;
constexpr size_t OFF_H    = OFF_X + 33554432;
constexpr size_t OFF_PR   = OFF_H + 16777216;
constexpr size_t OFF_WTIN = OFF_PR + 69206016;
constexpr size_t WTIN_L0 = 0, WTIN_L1 = 5242880, WTIN_L2 = WTIN_L1 + 8388608, WTIN_L3 = WTIN_L2 + 8650752;
constexpr size_t OFF_WTOUT = OFF_WTIN + 27525120;
constexpr size_t OFF_QN   = OFF_WTOUT + 8388608;
constexpr size_t OFF_KN   = OFF_QN + 16777216;
constexpr size_t OFF_VV   = OFF_KN + 16777216;
constexpr size_t OFF_TM   = OFF_VV + 16777216;
constexpr size_t OFF_OFB  = OFF_TM + 16777216;
constexpr size_t OFF_MOD  = OFF_OFB + 33554432;
constexpr size_t OFF_GATES= OFF_MOD + 245760;
constexpr size_t OFF_GB   = OFF_GATES + 1048576;
constexpr size_t OFF_ROPE = OFF_GB + 1048576;
constexpr size_t OFF_LAM  = OFF_ROPE + 8192;
constexpr size_t OFF_BAR  = OFF_LAM + 256;
constexpr size_t OFF_CK0  = OFF_BAR + 16384;
constexpr size_t OFF_CV0  = OFF_CK0 + 1048576;
constexpr size_t OFF_CK3  = OFF_CV0 + 1048576;
constexpr size_t OFF_CV3  = OFF_CK3 + 1048576;
constexpr size_t OFF_SS   = OFF_CV3 + 1048576;
constexpr size_t OFF_SW   = OFF_SS + 131072;
constexpr size_t WS_END   = OFF_SW + 337920;
constexpr size_t OFF_HR   = OFF_OFB + 8388608;
constexpr size_t OFF_CK1  = OFF_OFB;
constexpr size_t OFF_CV1  = OFF_OFB + 4194304;
constexpr size_t OFF_VT   = OFF_VV;

constexpr size_t OUT_Y = 0, OUT_L0K = 8388608, OUT_L0V = 9437184, OUT_L1K = 10485760, OUT_L1V = 14680064,
                 OUT_L2S = 18874368, OUT_L3K = 23068672, OUT_L3V = 24117248;

constexpr int SMEM_BYTES = 77824;
constexpr float NORM_EPS = 1e-6f;

struct Params {
  const float* in[43];
  float* out;
  char* ws;
};

__host__ __device__ constexpr int lbase(int l) { return l == 0 ? 11 : (l == 1 ? 17 : (l == 2 ? 27 : 36)); }

typedef __bf16 bf16x2_t __attribute__((ext_vector_type(2)));
typedef float f32x2_t __attribute__((ext_vector_type(2)));
DI u16 f2bf(float x) { __bf16 b = (__bf16)x; return __builtin_bit_cast(u16, b); }
DI float bf2f(u16 h) { return __uint_as_float(((unsigned)h) << 16); }
DI unsigned pack2(float a, float b) { f32x2_t v = {a, b}; bf16x2_t r = __builtin_convertvector(v, bf16x2_t); return __builtin_bit_cast(unsigned, r); }
DI float silu(float x) { return x / (1.f + __expf(-x)); }
DI float wave_sum(float v) { for (int o = 32; o; o >>= 1) v += __shfl_xor(v, o); return v; }
DI float grp16_sum(float v) { v += __shfl_xor(v, 1); v += __shfl_xor(v, 2); v += __shfl_xor(v, 4); v += __shfl_xor(v, 8); return v; }
DI float grp16_max(float v) { v = fmaxf(v, __shfl_xor(v, 1)); v = fmaxf(v, __shfl_xor(v, 2)); v = fmaxf(v, __shfl_xor(v, 4)); v = fmaxf(v, __shfl_xor(v, 8)); return v; }
DI f32x4 mfma(bf16x8 a, bf16x8 b, f32x4 c) { return __builtin_amdgcn_mfma_f32_16x16x32_bf16(a, b, c, 0, 0, 0); }
DI bf16x8 ldf(const u16* p) { return *reinterpret_cast<const bf16x8*>(p); }
DI f32x4 zero4() { f32x4 z = {0.f, 0.f, 0.f, 0.f}; return z; }
DI float4 ntload4(const float* p) { const f32x4 v = __builtin_nontemporal_load(reinterpret_cast<const f32x4*>(p)); return make_float4(v[0], v[1], v[2], v[3]); }
typedef unsigned u32x4_t __attribute__((ext_vector_type(4)));
DI uint4 ntload_u4(const void* p) { const u32x4_t v = __builtin_nontemporal_load(reinterpret_cast<const u32x4_t*>(p)); return make_uint4(v[0], v[1], v[2], v[3]); }
DI void ntstore4(float* p, float4 o) { f32x4 v = {o.x, o.y, o.z, o.w}; __builtin_nontemporal_store(v, reinterpret_cast<f32x4*>(p)); }

DI void phase0(const Params& p, char* smem) {
  const int tid = threadIdx.x;
  constexpr int NT_MOD = 384, NT_TR = 1680 + 512 + 384, NT_CK = 768;
  for (int task = blockIdx.x; task < NT_MOD + NT_TR + NT_CK + 1; task += gridDim.x) {
    __syncthreads();
    if (task < NT_MOD) {
      const int l = task / 96, cgp = task % 96;
      float* sc = (float*)smem;
      float* red = sc + 5 * 1024;
      for (int i = tid; i < 5 * 1024; i += 256) {
        int c = i >> 10, k = i & 1023;
        float v = (c == 0) ? p.in[10][k] : p.in[9][(c - 1) * 1024 + k];
        sc[i] = v / (1.f + expf(-v));
      }
      __syncthreads();
      const float* W = p.in[lbase(l) + 1];
      const float* mb = p.in[lbase(l) + 2];
      const int kg = tid >> 3, cp = tid & 7, n = cgp * 32 + cp * 4;
      float4 a[5];
#pragma unroll
      for (int c = 0; c < 5; ++c) a[c] = make_float4(0.f, 0.f, 0.f, 0.f);
      const float* wp = W + (size_t)(kg * 32) * 3072 + n;
#pragma unroll 16
      for (int k = 0; k < 32; ++k) {
        const float4 wv = ntload4(wp + (size_t)k * 3072);
#pragma unroll
        for (int c = 0; c < 5; ++c) { const float s = sc[c * 1024 + kg * 32 + k]; a[c].x += s * wv.x; a[c].y += s * wv.y; a[c].z += s * wv.z; a[c].w += s * wv.w; }
      }
#pragma unroll
      for (int c = 0; c < 5; ++c) *reinterpret_cast<float4*>(red + (kg * 5 + c) * 32 + cp * 4) = a[c];
      __syncthreads();
      float* MOD = (float*)(p.ws + OFF_MOD);
      if (tid < 160) {
        const int c = tid >> 5, col = tid & 31;
        float s = 0.f;
#pragma unroll
        for (int g = 0; g < 32; ++g) s += red[(g * 5 + c) * 32 + col];
        s += mb[cgp * 32 + col];
        MOD[(l * 5 + c) * 3072 + cgp * 32 + col] = s;
      }
    } else if (task < NT_MOD + NT_TR) {
      int tt = task - NT_MOD;
      const float* W; u16* WT; int N, sld, dld, kt, nt; bool vperm = false;
      if (tt < 1680) {
        int l, local, nn;
        if (tt < 320) { l = 0; local = tt; nn = 20; N = 2560; WT = (u16*)(p.ws + OFF_WTIN + WTIN_L0); }
        else if (tt < 832) { l = 1; local = tt - 320; nn = 32; N = 4096; WT = (u16*)(p.ws + OFF_WTIN + WTIN_L1); }
        else if (tt < 1360) { l = 2; local = tt - 832; nn = 33; N = 4128; WT = (u16*)(p.ws + OFF_WTIN + WTIN_L2); }
        else { l = 3; local = tt - 1360; nn = 20; N = 2560; WT = (u16*)(p.ws + OFF_WTIN + WTIN_L3); }
        W = p.in[lbase(l) + 3]; sld = N; dld = 1024;
        nt = (local % nn) * 2; kt = local / nn;
      } else if (tt < 2192) {
        int t2 = tt - 1680; int l = t2 >> 7; int local = t2 & 127;
        W = p.in[lbase(l) + 4]; WT = (u16*)(p.ws + OFF_WTOUT + (size_t)l * 2097152); N = 1024; sld = 1024; dld = 1024;
        nt = (local & 7) * 2; kt = local >> 3;
      } else {
        int t3 = tt - 2192, F, local; size_t doff;
        if (t3 < 64) { W = p.in[3]; F = 256; local = t3; doff = OFF_CV0; }
        else if (t3 < 128) { W = p.in[8]; F = 256; local = t3 - 64; doff = OFF_CV3; }
        else { W = p.in[5]; F = 1024; local = t3 - 128; doff = OFF_CV1; }
        const int per_b = 8 * (F / 128);
        const int b = local / per_b, r = local % per_b;
        kt = r & 7; nt = (r >> 3) * 2;
        W += (size_t)b * 512 * F; WT = (u16*)(p.ws + doff) + (size_t)b * F * 512; N = F; sld = F; dld = 512; vperm = true;
      }
      float* tl = (float*)smem;
      {
        const int kk0 = tid >> 4, nn = (tid & 15) * 4;
        float4 v4[2][4];
#pragma unroll
        for (int hh = 0; hh < 2; ++hh) {
          const int n = (nt + hh) * 64 + nn;
#pragma unroll
          for (int i = 0; i < 4; ++i)
            v4[hh][i] = (n < N) ? ntload4(W + (size_t)(kt * 64 + kk0 + 16 * i) * sld + n) : make_float4(0.f, 0.f, 0.f, 0.f);
        }
#pragma unroll
        for (int hh = 0; hh < 2; ++hh)
#pragma unroll
          for (int i = 0; i < 4; ++i) {
            float* d = tl + hh * 4160 + (kk0 + 16 * i) * 65 + nn;
            d[0] = v4[hh][i].x; d[1] = v4[hh][i].y; d[2] = v4[hh][i].z; d[3] = v4[hh][i].w;
          }
      }
      __syncthreads();
#pragma unroll
      for (int hh = 0; hh < 2; ++hh)
#pragma unroll
        for (int i = 0; i < 2; ++i) {
          const int nn = i * 32 + (tid >> 3), kc = tid & 7;
          const float* s = tl + hh * 4160 + (kc * 8) * 65 + nn;
          uint4 o;
          o.x = pack2(s[0], s[65]); o.y = pack2(s[130], s[195]); o.z = pack2(s[260], s[325]); o.w = pack2(s[390], s[455]);
          u16* dp = WT + (size_t)((nt + hh) * 64 + nn) * dld + kt * 64;
          if (vperm) {
            const int pb = (kc >> 2) * 32 + ((kc & 3) >> 1) * 4 + (kc & 1) * 16;
            uint2 lo2; lo2.x = o.x; lo2.y = o.y; uint2 hi2; hi2.x = o.z; hi2.y = o.w;
            *reinterpret_cast<uint2*>(dp + pb) = lo2;
            *reinterpret_cast<uint2*>(dp + pb + 8) = hi2;
          } else {
            *reinterpret_cast<uint4*>(dp + kc * 8) = o;
          }
        }
    } else if (task < NT_MOD + NT_TR + NT_CK) {
      int t4 = task - NT_MOD - NT_TR;
      const float* s; u16* d;
      if (t4 < 128) { s = p.in[2]; d = (u16*)(p.ws + OFF_CK0); }
      else if (t4 < 256) { s = p.in[7]; d = (u16*)(p.ws + OFF_CK3); t4 -= 128; }
      else { s = p.in[4]; d = (u16*)(p.ws + OFF_CK1); t4 -= 256; }
      const size_t base = (size_t)t4 * 4096 + tid * 16;
#pragma unroll
      for (int i = 0; i < 2; ++i) {
        const float4 a = ntload4(s + base + i * 8), b4 = ntload4(s + base + i * 8 + 4);
        uint4 o; o.x = pack2(a.x, a.y); o.y = pack2(a.z, a.w); o.z = pack2(b4.x, b4.y); o.w = pack2(b4.z, b4.w);
        *reinterpret_cast<uint4*>(d + base + i * 8) = o;
      }
    } else {
      float2* rope = (float2*)(p.ws + OFF_ROPE);
      for (int i = tid; i < 1024; i += 256) {
        int pos = i >> 4, f = i & 15;
        float inv = powf(10000.0f, -(float)f / 16.0f);
        float ang = (float)pos * inv;
        rope[i] = make_float2(cosf(ang), sinf(ang));
      }
      if (tid == 0) {
        float d1 = 0.f, d2 = 0.f;
        for (int i = 0; i < 64; ++i) { d1 += p.in[22][i] * p.in[23][i]; d2 += p.in[24][i] * p.in[25][i]; }
        float lam_init = 0.8f - 0.6f * expf(-0.3f);
        float* LAM = (float*)(p.ws + OFF_LAM);
        LAM[0] = expf(d1) - expf(d2) + lam_init;
        LAM[1] = lam_init;
        LAM[2] = 0.f;
      }
      {
        float4* ssz = (float4*)(p.ws + OFF_SS);
        for (int i = tid; i < 8192; i += 256) ssz[i] = make_float4(0.f, 0.f, 0.f, 0.f);
      }
    }
  }
}

DI void sw_tasks(const Params& p) {
  const int lane = threadIdx.x & 63, w = threadIdx.x >> 6;
  const float* MOD = (const float*)(p.ws + OFF_MOD);
  float* SW = (float*)(p.ws + OFF_SW);
  for (int task = blockIdx.x * 4 + w; task < 1348; task += gridDim.x * 4) {
    int l, t8; const u16* WT;
    if (task < 512) { l = 1; t8 = task; WT = (const u16*)(p.ws + OFF_WTIN + WTIN_L1); }
    else if (task < 1028) { l = 2; t8 = task - 512; WT = (const u16*)(p.ws + OFF_WTIN + WTIN_L2); }
    else { l = 3; t8 = task - 1028; WT = (const u16*)(p.ws + OFF_WTIN + WTIN_L3); }
    float sh[5][16];
#pragma unroll
    for (int c = 0; c < 5; ++c)
#pragma unroll
      for (int q4 = 0; q4 < 4; ++q4) {
        const float4 v = *reinterpret_cast<const float4*>(MOD + (size_t)(l * 5 + c) * 3072 + lane * 16 + q4 * 4);
        sh[c][q4 * 4] = v.x; sh[c][q4 * 4 + 1] = v.y; sh[c][q4 * 4 + 2] = v.z; sh[c][q4 * 4 + 3] = v.w;
      }
#pragma unroll 2
    for (int r = 0; r < 8; ++r) {
      const int n = t8 * 8 + r;
      const uint4 w0 = *reinterpret_cast<const uint4*>(WT + (size_t)n * 1024 + lane * 16);
      const uint4 w1 = *reinterpret_cast<const uint4*>(WT + (size_t)n * 1024 + lane * 16 + 8);
      float wf[16];
      wf[0] = bf2f((u16)(w0.x & 0xffff)); wf[1] = bf2f((u16)(w0.x >> 16)); wf[2] = bf2f((u16)(w0.y & 0xffff)); wf[3] = bf2f((u16)(w0.y >> 16));
      wf[4] = bf2f((u16)(w0.z & 0xffff)); wf[5] = bf2f((u16)(w0.z >> 16)); wf[6] = bf2f((u16)(w0.w & 0xffff)); wf[7] = bf2f((u16)(w0.w >> 16));
      wf[8] = bf2f((u16)(w1.x & 0xffff)); wf[9] = bf2f((u16)(w1.x >> 16)); wf[10] = bf2f((u16)(w1.y & 0xffff)); wf[11] = bf2f((u16)(w1.y >> 16));
      wf[12] = bf2f((u16)(w1.z & 0xffff)); wf[13] = bf2f((u16)(w1.z >> 16)); wf[14] = bf2f((u16)(w1.w & 0xffff)); wf[15] = bf2f((u16)(w1.w >> 16));
#pragma unroll
      for (int c = 0; c < 5; ++c) {
        float s = 0.f;
#pragma unroll
        for (int k = 0; k < 16; ++k) s += sh[c][k] * wf[k];
        s = wave_sum(s);
        if (lane == 0) SW[(size_t)(l * 5 + c) * 4224 + n] = s;
      }
    }
  }
}

DI void norm_phase(const Params& p, int layer) {
  const int lane = threadIdx.x & 63, w = threadIdx.x >> 6;
  float* X = (float*)(p.ws + OFF_X);
  u16* H = (u16*)(p.ws + OFF_H);
  const float* MOD = (const float*)(p.ws + OFF_MOD);
  const float* nw = (layer < 4) ? p.in[lbase(layer)] : p.in[42];
  for (int r = blockIdx.x * 4 + w; r < 8192; r += gridDim.x * 4) {
    const float* src = (layer == 0) ? (r < 4096 ? p.in[0] + (size_t)r * 1024 : p.in[1] + (size_t)(r - 4096) * 1024) : X + (size_t)r * 1024;
    float4 v[4];
    float ss = 0.f;
#pragma unroll
    for (int i = 0; i < 4; ++i) {
      v[i] = (layer == 4) ? ntload4(src + (i * 64 + lane) * 4) : *reinterpret_cast<const float4*>(src + (i * 64 + lane) * 4);
      ss += v[i].x * v[i].x + v[i].y * v[i].y + v[i].z * v[i].z + v[i].w * v[i].w;
    }
    ss = wave_sum(ss);
    const float rs = rsqrtf(ss * (1.f / 1024.f) + NORM_EPS);
    if (layer < 4) {
      const int cond = r < 4096 ? 0 : 1 + ((r - 4096) >> 10);
      const float* md = MOD + (size_t)(layer * 5 + cond) * 3072;
#pragma unroll
      for (int i = 0; i < 4; ++i) {
        const int n = (i * 64 + lane) * 4;
        float4 g = *reinterpret_cast<const float4*>(nw + n);
        float4 sh = *reinterpret_cast<const float4*>(md + n);
        float4 sc = *reinterpret_cast<const float4*>(md + 1024 + n);
        float h0 = v[i].x * rs * g.x * (1.f + sc.x) + sh.x;
        float h1 = v[i].y * rs * g.y * (1.f + sc.y) + sh.y;
        float h2 = v[i].z * rs * g.z * (1.f + sc.z) + sh.z;
        float h3 = v[i].w * rs * g.w * (1.f + sc.w) + sh.w;
        uint2 pk; pk.x = pack2(h0, h1); pk.y = pack2(h2, h3);
        *reinterpret_cast<uint2*>(H + (size_t)r * 1024 + n) = pk;
      }
    } else {
#pragma unroll
      for (int i = 0; i < 4; ++i) {
        const int n = (i * 64 + lane) * 4;
        float4 g = *reinterpret_cast<const float4*>(nw + n);
        float4 o; o.x = v[i].x * rs * g.x; o.y = v[i].y * rs * g.y; o.z = v[i].z * rs * g.z; o.w = v[i].w * rs * g.w;
        ntstore4(p.out + OUT_Y + (size_t)r * 1024 + n, o);
      }
    }
  }
}

struct EpiArgs {
  int kind;
  int ld;
  int rope_end;
  int k_beg, k_end, v_end, kw;
  float* outk; float* outv;
  int layer;
  int fused;
};

DI void gemm_phase(const Params& p, char* smem, const u16* __restrict__ A, const u16* __restrict__ WT, int ntn, const EpiArgs e) {
  u16* As = (u16*)smem;
  u16* Bs = As + 2 * 128 * 64;
  const int tid = threadIdx.x, lane = tid & 63, w = tid >> 6, wm = w >> 1, wn = w & 1, l16 = lane & 15, quad = lane >> 4;
  const int ntiles = 64 * ntn;
  u16* PR = (u16*)(p.ws + OFF_PR);
  const int xg = blockIdx.x & 7, xl = blockIdx.x >> 3, xn = gridDim.x >> 3;
  (void)ntiles;
  for (int t = xl; t < 8 * ntn; t += xn) {
    const int tm = xg * 8 + (t & 7), tn = t >> 3;
    const int m0 = tm * 128, n0 = tn * 128;
    f32x4 acc[4][4];
#pragma unroll
    for (int i = 0; i < 4; ++i)
#pragma unroll
      for (int j = 0; j < 4; ++j) acc[i][j] = zero4();
    const u16* Ag = A + (size_t)m0 * 1024;
    const u16* Bg = WT + (size_t)n0 * 1024;
    const int lrow = tid >> 3, lkc = tid & 7;
    const char* Abase = (const char*)A;
    const char* Bbase = (const char*)WT;
    const unsigned aoff = (unsigned)((m0 + lrow) * 1024 + lkc * 8) * 2u;
    const unsigned boff = (unsigned)((n0 + lrow) * 1024 + lkc * 8) * 2u;
    u16* Ast = As + lrow * 64 + ((lkc ^ (lrow & 7)) * 8);
    u16* Bst = Bs + lrow * 64 + ((lkc ^ (lrow & 7)) * 8);
#define G_LD1(base_, off_) (*reinterpret_cast<const uint4*>((base_) + (off_)))
#define G_LOAD(S, kt_) \
    S##a0 = G_LD1(Abase, aoff + (unsigned)(kt_) * 128u); S##a1 = G_LD1(Abase, aoff + 65536u + (unsigned)(kt_) * 128u); \
    S##a2 = G_LD1(Abase, aoff + 131072u + (unsigned)(kt_) * 128u); S##a3 = G_LD1(Abase, aoff + 196608u + (unsigned)(kt_) * 128u); \
    S##b0 = G_LD1(Bbase, boff + (unsigned)(kt_) * 128u); S##b1 = G_LD1(Bbase, boff + 65536u + (unsigned)(kt_) * 128u); \
    S##b2 = G_LD1(Bbase, boff + 131072u + (unsigned)(kt_) * 128u); S##b3 = G_LD1(Bbase, boff + 196608u + (unsigned)(kt_) * 128u);
#define G_STORE(S, buf_) \
    *reinterpret_cast<uint4*>(Ast + (buf_) * 8192) = S##a0; *reinterpret_cast<uint4*>(Ast + (buf_) * 8192 + 32 * 64) = S##a1; \
    *reinterpret_cast<uint4*>(Ast + (buf_) * 8192 + 64 * 64) = S##a2; *reinterpret_cast<uint4*>(Ast + (buf_) * 8192 + 96 * 64) = S##a3; \
    *reinterpret_cast<uint4*>(Bst + (buf_) * 8192) = S##b0; *reinterpret_cast<uint4*>(Bst + (buf_) * 8192 + 32 * 64) = S##b1; \
    *reinterpret_cast<uint4*>(Bst + (buf_) * 8192 + 64 * 64) = S##b2; *reinterpret_cast<uint4*>(Bst + (buf_) * 8192 + 96 * 64) = S##b3;
#define G_COMPUTE(buf_) { \
      const u16* Ab = As + (buf_) * 8192 + (wm * 64 + l16) * 64; \
      const u16* Bb = Bs + (buf_) * 8192 + (wn * 64 + l16) * 64; \
      _Pragma("unroll") for (int ks = 0; ks < 2; ++ks) { \
        const int co = ((ks * 4 + quad) ^ (l16 & 7)) * 8; \
        bf16x8 af0 = ldf(Ab + co), af1 = ldf(Ab + 16 * 64 + co), af2 = ldf(Ab + 32 * 64 + co), af3 = ldf(Ab + 48 * 64 + co); \
        bf16x8 bf0 = ldf(Bb + co), bf1 = ldf(Bb + 16 * 64 + co), bf2 = ldf(Bb + 32 * 64 + co), bf3 = ldf(Bb + 48 * 64 + co); \
        acc[0][0] = mfma(bf0, af0, acc[0][0]); acc[0][1] = mfma(bf1, af0, acc[0][1]); acc[0][2] = mfma(bf2, af0, acc[0][2]); acc[0][3] = mfma(bf3, af0, acc[0][3]); \
        acc[1][0] = mfma(bf0, af1, acc[1][0]); acc[1][1] = mfma(bf1, af1, acc[1][1]); acc[1][2] = mfma(bf2, af1, acc[1][2]); acc[1][3] = mfma(bf3, af1, acc[1][3]); \
        acc[2][0] = mfma(bf0, af2, acc[2][0]); acc[2][1] = mfma(bf1, af2, acc[2][1]); acc[2][2] = mfma(bf2, af2, acc[2][2]); acc[2][3] = mfma(bf3, af2, acc[2][3]); \
        acc[3][0] = mfma(bf0, af3, acc[3][0]); acc[3][1] = mfma(bf1, af3, acc[3][1]); acc[3][2] = mfma(bf2, af3, acc[3][2]); acc[3][3] = mfma(bf3, af3, acc[3][3]); \
      } }
    uint4 Ra0, Ra1, Ra2, Ra3, Rb0, Rb1, Rb2, Rb3, Qa0, Qa1, Qa2, Qa3, Qb0, Qb1, Qb2, Qb3;
    G_LOAD(R, 0)
    G_LOAD(Q, 1)
    __syncthreads();
    G_STORE(R, 0)
    __syncthreads();
    for (int kt = 0; kt < 16; kt += 2) {
      const int k2 = kt + 2 < 16 ? kt + 2 : 14, k3 = kt + 3 < 16 ? kt + 3 : 15;
#define G_SCHED \
      __builtin_amdgcn_sched_group_barrier(0x100, 6, 0); \
      _Pragma("unroll") for (int sg_ = 0; sg_ < 2; ++sg_) { __builtin_amdgcn_sched_group_barrier(0x008, 1, 0); __builtin_amdgcn_sched_group_barrier(0x100, 1, 0); } \
      _Pragma("unroll") for (int sg_ = 0; sg_ < 8; ++sg_) { __builtin_amdgcn_sched_group_barrier(0x008, 2, 0); __builtin_amdgcn_sched_group_barrier(0x020, 1, 0); __builtin_amdgcn_sched_group_barrier(0x100, 1, 0); } \
      _Pragma("unroll") for (int sg_ = 0; sg_ < 7; ++sg_) { __builtin_amdgcn_sched_group_barrier(0x008, 2, 0); __builtin_amdgcn_sched_group_barrier(0x200, 1, 0); } \
      __builtin_amdgcn_sched_group_barrier(0x200, 1, 0);
      __builtin_amdgcn_sched_barrier(0);
      __builtin_amdgcn_s_setprio(1);
      G_LOAD(R, k2)
      G_COMPUTE(0)
      G_STORE(Q, 1)
      G_SCHED
      __builtin_amdgcn_sched_barrier(0);
      __builtin_amdgcn_s_setprio(0);
      __syncthreads();
      __builtin_amdgcn_s_setprio(1);
      G_LOAD(Q, k3)
      G_COMPUTE(1)
      G_STORE(R, 0)
      G_SCHED
      __builtin_amdgcn_sched_barrier(0);
      __builtin_amdgcn_s_setprio(0);
      __syncthreads();
#undef G_SCHED
    }
#undef G_LOAD
#undef G_LD1
#undef G_STORE
#undef G_COMPUTE
    const int nw = n0 + wn * 64;
    const int rbase = m0 + wm * 64 + l16;
    const int cq = quad * 4;
    if (e.kind <= 1 && e.fused) {
      const int cond = m0 < 4096 ? 0 : 1 + ((m0 - 4096) >> 10);
      const float* SS = (const float*)(p.ws + OFF_SS) + (size_t)e.layer * 8192;
      const float* SW = (const float*)(p.ws + OFF_SW) + (size_t)(e.layer * 5 + cond) * 4224 + nw + cq;
      float4 sw[4];
#pragma unroll
      for (int nb = 0; nb < 4; ++nb) sw[nb] = *reinterpret_cast<const float4*>(SW + nb * 16);
#pragma unroll
      for (int mb = 0; mb < 4; ++mb) {
        const float rs = rsqrtf(SS[rbase + mb * 16] * (1.f / 1024.f) + NORM_EPS);
#pragma unroll
        for (int nb = 0; nb < 4; ++nb) {
          acc[mb][nb][0] = rs * acc[mb][nb][0] + sw[nb].x; acc[mb][nb][1] = rs * acc[mb][nb][1] + sw[nb].y;
          acc[mb][nb][2] = rs * acc[mb][nb][2] + sw[nb].z; acc[mb][nb][3] = rs * acc[mb][nb][3] + sw[nb].w;
        }
      }
    }
    if (e.kind == 0) {
      const bool lat = m0 >= 4096;
      const bool do_rope = lat && nw < e.rope_end;
      const bool is_v = nw >= e.k_end && nw < e.v_end;
      const float2* rope = (const float2*)(p.ws + OFF_ROPE);
      if (!is_v) {
#pragma unroll
        for (int mb = 0; mb < 4; ++mb) {
          const int row = rbase + mb * 16;
          if (do_rope) {
            const int t = (row - 4096) & 1023;
            const float2* rr = rope + (t >> 6) * 16 + cq;
            const float2* rc = rope + (t & 63) * 16 + cq;
#pragma unroll
            for (int r = 0; r < 4; ++r) {
              const float2 cr = rr[r], cc = rc[r];
              const float v0 = acc[mb][0][r], v1 = acc[mb][1][r], v2 = acc[mb][2][r], v3 = acc[mb][3][r];
              acc[mb][0][r] = v0 * cr.x - v1 * cr.y; acc[mb][1][r] = v1 * cr.x + v0 * cr.y;
              acc[mb][2][r] = v2 * cc.x - v3 * cc.y; acc[mb][3][r] = v3 * cc.x + v2 * cc.y;
            }
          }
          u16* dst = PR + (size_t)row * e.ld + nw + cq;
#pragma unroll
          for (int nb = 0; nb < 4; ++nb) {
            uint2 pk; pk.x = pack2(acc[mb][nb][0], acc[mb][nb][1]); pk.y = pack2(acc[mb][nb][2], acc[mb][nb][3]);
            *reinterpret_cast<uint2*>(dst + nb * 16) = pk;
          }
        }
      } else {
        u16* Vst = (u16*)smem + w * (64 * 72);
#pragma unroll
        for (int mb = 0; mb < 4; ++mb)
#pragma unroll
          for (int nb = 0; nb < 4; ++nb)
#pragma unroll
            for (int r = 0; r < 4; ++r)
              Vst[(nb * 16 + cq + r) * 72 + (mb >> 1) * 32 + ((l16 >> 2) & 3) * 8 + (mb & 1) * 4 + (l16 & 3)] = f2bf(acc[mb][nb][r]);
        __builtin_amdgcn_fence(__ATOMIC_RELEASE, "wavefront");
        __builtin_amdgcn_s_waitcnt(0xc07f);
        __builtin_amdgcn_wave_barrier();
        u16* VT = (u16*)(p.ws + OFF_VT);
#pragma unroll
        for (int i = 0; i < 8; ++i) {
          const int c = lane + 64 * i, col = c >> 3, rc = c & 7;
          const uint4 v = *reinterpret_cast<const uint4*>(Vst + col * 72 + rc * 8);
          *reinterpret_cast<uint4*>(VT + (size_t)(nw - e.k_end + col) * 8192 + m0 + wm * 64 + rc * 8) = v;
        }
      }
      if (!lat && nw >= e.k_beg && nw < e.v_end) {
        float* ob = (nw < e.k_end) ? e.outk + (nw - e.k_beg) : e.outv + (nw - e.k_end);
#pragma unroll
        for (int mb = 0; mb < 4; ++mb) {
          float* o = ob + (size_t)(rbase + mb * 16) * e.kw + cq;
#pragma unroll
          for (int nb = 0; nb < 4; ++nb) {
            float4 v; v.x = acc[mb][nb][0]; v.y = acc[mb][nb][1]; v.z = acc[mb][nb][2]; v.w = acc[mb][nb][3];
            ntstore4(o + nb * 16, v);
          }
        }
      }
    } else if (e.kind == 1) {
      float* GATES = (float*)(p.ws + OFF_GATES);
#pragma unroll
      for (int mb = 0; mb < 4; ++mb) {
        const int row = rbase + mb * 16;
#pragma unroll
        for (int nb = 0; nb < 4; ++nb) {
          const int col = nw + nb * 16 + cq;
          if (col < 4096) {
            uint2 pk; pk.x = pack2(acc[mb][nb][0], acc[mb][nb][1]); pk.y = pack2(acc[mb][nb][2], acc[mb][nb][3]);
            *reinterpret_cast<uint2*>(PR + (size_t)row * 4224 + col) = pk;
          } else if (col < 4128) {
            float4 v; v.x = acc[mb][nb][0]; v.y = acc[mb][nb][1]; v.z = acc[mb][nb][2]; v.w = acc[mb][nb][3];
            *reinterpret_cast<float4*>(GATES + (size_t)row * 32 + (col - 4096)) = v;
          }
        }
      }
    } else {
      float* X = (float*)(p.ws + OFF_X);
      const float* MOD = (const float*)(p.ws + OFF_MOD);
      const int cond = m0 < 4096 ? 0 : 1 + ((m0 - 4096) >> 10);
      const float* gate = MOD + (size_t)(e.layer * 5 + cond) * 3072 + 2048;
      const float gsc = (e.kind == 3) ? ((const float*)(p.ws + OFF_LAM))[2] : 1.f;
      const float* nwn = p.in[lbase(e.layer < 3 ? e.layer + 1 : 3)];
      const float* scn = MOD + (size_t)((e.layer < 3 ? e.layer + 1 : 3) * 5 + cond) * 3072 + 1024;
      u16* HR = (u16*)(p.ws + OFF_HR);
      float ssp[4] = {0.f, 0.f, 0.f, 0.f};
#pragma unroll
      for (int nb = 0; nb < 4; ++nb) {
        const int col = nw + nb * 16 + cq;
        float4 g = *reinterpret_cast<const float4*>(gate + col);
        g.x *= gsc; g.y *= gsc; g.z *= gsc; g.w *= gsc;
        float4 gm = make_float4(0.f, 0.f, 0.f, 0.f);
        if (e.fused) {
          const float4 a = *reinterpret_cast<const float4*>(nwn + col), b = *reinterpret_cast<const float4*>(scn + col);
          gm.x = a.x * (1.f + b.x); gm.y = a.y * (1.f + b.y); gm.z = a.z * (1.f + b.z); gm.w = a.w * (1.f + b.w);
        }
#pragma unroll
        for (int mb = 0; mb < 4; ++mb) {
          const int xrow = rbase + mb * 16;
          float* xp = X + (size_t)xrow * 1024 + col;
          const float* xs = (e.layer == 0) ? (xrow < 4096 ? p.in[0] + (size_t)xrow * 1024 + col : p.in[1] + (size_t)(xrow - 4096) * 1024 + col) : xp;
          float4 x = (e.layer == 0) ? ntload4(xs) : *reinterpret_cast<const float4*>(xs);
          x.x += g.x * acc[mb][nb][0]; x.y += g.y * acc[mb][nb][1]; x.z += g.z * acc[mb][nb][2]; x.w += g.w * acc[mb][nb][3];
          *reinterpret_cast<float4*>(xp) = x;
          if (e.fused) {
            ssp[mb] += x.x * x.x + x.y * x.y + x.z * x.z + x.w * x.w;
            uint2 pk; pk.x = pack2(x.x * gm.x, x.y * gm.y); pk.y = pack2(x.z * gm.z, x.w * gm.w);
            *reinterpret_cast<uint2*>(HR + (size_t)(rbase + mb * 16) * 1024 + col) = pk;
          }
        }
      }
      if (e.fused) {
        float* SSn = (float*)(p.ws + OFF_SS) + (size_t)(e.layer + 1) * 8192;
#pragma unroll
        for (int mb = 0; mb < 4; ++mb) {
          float s = ssp[mb];
          s += __shfl_xor(s, 16); s += __shfl_xor(s, 32);
          if (quad == 0) atomicAdd(SSn + rbase + mb * 16, s);
        }
      }
    }
  }
}

struct AttnItem {
  const u16* kb; int ldk;
  const u16* vtb;
  const u16* kc; int ldkc;
  const u16* vtc;
  int t_lo, n_loc, n_cache, mask;
};

template <int KW, int NDV>
DI void attn_core(char* smem, const AttnItem& it, const bf16x8 (&qf)[2][2], int koff, int qi0,
                  f32x4 (&O)[NDV][2], float (&mrun)[2], float (&lrun)[2]) {
  constexpr int KLD = KW + 16;
  constexpr int NKC = KW / 32;
  constexpr int NVC = NDV / 2;
  u16* Ks = (u16*)smem;
  u16* Vt = Ks + 64 * KLD;
  const int tid = threadIdx.x, lane = tid & 63, l16 = lane & 15, quad = lane >> 4;
  const int ntile = it.n_loc + it.n_cache;
  const int krow = tid / (KW / 8), kdc = tid % (KW / 8);
  const int vrow = tid >> 3, vdc = tid & 7;
  constexpr int KRS = 2048 / KW;
  uint4 pk0, pk1, pk2, pk3, pv0, pv1, pv2, pv3;
  uint4 qk0, qk1, qk2, qk3, qv0, qv1, qv2, qv3;
  pk2 = pk3 = pv2 = pv3 = make_uint4(0u, 0u, 0u, 0u);
  qk0 = qk1 = qk2 = qk3 = qv0 = qv1 = qv2 = qv3 = make_uint4(0u, 0u, 0u, 0u);
  constexpr bool DIST2 = (NKC == 2);
  int ld_ = it.ldk, vld_ = 8192;
  const u16* kp_ = it.kb + (size_t)(it.t_lo * 64 + krow) * it.ldk + kdc * 8;
  const u16* vp_ = it.vtb + (size_t)vrow * 8192 + it.t_lo * 64 + vdc * 8;
#define A_GLOAD(S, t_) do { \
    if ((t_) == it.n_loc) { ld_ = it.ldkc; vld_ = 512; kp_ = it.kc + (size_t)krow * it.ldkc + kdc * 8; vp_ = it.vtc + (size_t)vrow * 512 + vdc * 8; } \
    S##k0 = *reinterpret_cast<const uint4*>(kp_); S##k1 = *reinterpret_cast<const uint4*>(kp_ + (size_t)KRS * ld_); \
    if (NKC > 2) { S##k2 = *reinterpret_cast<const uint4*>(kp_ + (size_t)2 * KRS * ld_); S##k3 = *reinterpret_cast<const uint4*>(kp_ + (size_t)3 * KRS * ld_); } \
    S##v0 = *reinterpret_cast<const uint4*>(vp_); S##v1 = *reinterpret_cast<const uint4*>(vp_ + (size_t)32 * vld_); \
    if (NVC > 2) { S##v2 = *reinterpret_cast<const uint4*>(vp_ + (size_t)64 * vld_); S##v3 = *reinterpret_cast<const uint4*>(vp_ + (size_t)96 * vld_); } \
    kp_ += (size_t)64 * ld_; vp_ += 64; \
  } while (0)
#define A_LSTORE(S, buf_) do { \
      u16* kd = Ks + (buf_) * BUFE + krow * KLD + kdc * 8; \
      *reinterpret_cast<uint4*>(kd) = S##k0; *reinterpret_cast<uint4*>(kd + KRS * KLD) = S##k1; \
      if (NKC > 2) { *reinterpret_cast<uint4*>(kd + 2 * KRS * KLD) = S##k2; *reinterpret_cast<uint4*>(kd + 3 * KRS * KLD) = S##k3; } \
      u16* vd = Vt + (buf_) * BUFE + vrow * 80 + vdc * 8; \
      *reinterpret_cast<uint4*>(vd) = S##v0; *reinterpret_cast<uint4*>(vd + 32 * 80) = S##v1; \
      if (NVC > 2) { *reinterpret_cast<uint4*>(vd + 64 * 80) = S##v2; *reinterpret_cast<uint4*>(vd + 96 * 80) = S##v3; } \
    } while (0)
  constexpr int BUFE = 64 * KLD + NDV * 16 * 80;
  constexpr float SC = 0.125f * 1.4426950408889634f;
  constexpr bool PAIR = DIST2;
  constexpr int NKB = PAIR ? 8 : 4;
  const int niter = PAIR ? (ntile + 1) / 2 : ntile;
  A_GLOAD(p, 0);
  if (PAIR) { if (ntile > 1) A_GLOAD(q, 1); }
  __syncthreads();
  A_LSTORE(p, 0);
  if (PAIR) { if (ntile > 1) A_LSTORE(q, 1); }
  __syncthreads();
  if (PAIR) { if (ntile > 2) A_GLOAD(p, 2); if (ntile > 3) A_GLOAD(q, 3); } else { if (ntile > 1) A_GLOAD(p, 1); }
  for (int itn = 0; itn < niter; ++itn) {
    const int t = PAIR ? 2 * itn : itn;
    const bool two = PAIR && (t + 1 < ntile);
    const u16* Kb0 = Ks + (PAIR ? 0 : (t & 1)) * BUFE;
    const u16* Vb0 = Vt + (PAIR ? 0 : (t & 1)) * BUFE;
    const u16* Kb1 = Ks + BUFE;
    const u16* Vb1 = Vt + BUFE;
    f32x4 S[2][NKB];
#pragma unroll
    for (int nq = 0; nq < 2; ++nq)
#pragma unroll
      for (int kb = 0; kb < NKB; ++kb) S[nq][kb] = zero4();
    __builtin_amdgcn_s_setprio(1);
#pragma unroll
    for (int kb = 0; kb < 4; ++kb)
#pragma unroll
      for (int ks = 0; ks < 2; ++ks) {
        const bf16x8 kf = ldf(Kb0 + (kb * 16 + l16) * KLD + koff + ks * 32 + quad * 8);
        S[0][kb] = mfma(kf, qf[0][ks], S[0][kb]);
        S[1][kb] = mfma(kf, qf[1][ks], S[1][kb]);
      }
    if (PAIR) {
      if (two) {
#pragma unroll
        for (int kb = 0; kb < 4; ++kb)
#pragma unroll
          for (int ks = 0; ks < 2; ++ks) {
            const bf16x8 kf = ldf(Kb1 + (kb * 16 + l16) * KLD + koff + ks * 32 + quad * 8);
            S[0][NKB - 4 + kb] = mfma(kf, qf[0][ks], S[0][NKB - 4 + kb]);
            S[1][NKB - 4 + kb] = mfma(kf, qf[1][ks], S[1][NKB - 4 + kb]);
          }
      } else {
#pragma unroll
        for (int kb = 0; kb < 4; ++kb) {
          f32x4 neg = {-1e30f, -1e30f, -1e30f, -1e30f};
          S[0][NKB - 4 + kb] = neg; S[1][NKB - 4 + kb] = neg;
        }
      }
    }
    __builtin_amdgcn_s_setprio(0);
    const bool mask0 = it.mask && (t < it.n_loc);
    const bool mask1 = PAIR && it.mask && (t + 1 < it.n_loc);
    const int key00 = (it.t_lo + t) * 64;
    bf16x8 P[2][NKB / 2];
#pragma unroll
    for (int nq = 0; nq < 2; ++nq) {
      float mx = -1e30f;
      const int qi = qi0 + nq * 16 + l16;
#pragma unroll
      for (int kb = 0; kb < NKB; ++kb)
#pragma unroll
        for (int j = 0; j < 4; ++j) {
          float v = S[nq][kb][j];
          if (kb < 4 ? mask0 : mask1) {
            const int d = (key00 + kb * 16 + quad * 4 + j) - qi;
            if (d > 128 || d < -128) v = -1e30f;
            S[nq][kb][j] = v;
          }
          mx = fmaxf(mx, v);
        }
      mx = fmaxf(mx, __shfl_xor(mx, 16));
      mx = fmaxf(mx, __shfl_xor(mx, 32));
      const float mnew = fmaxf(mrun[nq], mx);
      const float alpha = __builtin_amdgcn_exp2f((mrun[nq] - mnew) * SC);
      const float mb = -mnew * SC;
      mrun[nq] = mnew;
      float ls = 0.f;
#pragma unroll
      for (int kb = 0; kb < NKB; ++kb)
#pragma unroll
        for (int j = 0; j < 4; ++j) { const float pe = __builtin_amdgcn_exp2f(fmaf(S[nq][kb][j], SC, mb)); S[nq][kb][j] = pe; ls += pe; }
      lrun[nq] = lrun[nq] * alpha + ls;
#pragma unroll
      for (int dvb = 0; dvb < NDV; ++dvb) { O[dvb][nq][0] *= alpha; O[dvb][nq][1] *= alpha; O[dvb][nq][2] *= alpha; O[dvb][nq][3] *= alpha; }
#pragma unroll
      for (int ks = 0; ks < NKB / 2; ++ks) {
        uint4 u;
        u.x = pack2(S[nq][2 * ks][0], S[nq][2 * ks][1]); u.y = pack2(S[nq][2 * ks][2], S[nq][2 * ks][3]);
        u.z = pack2(S[nq][2 * ks + 1][0], S[nq][2 * ks + 1][1]); u.w = pack2(S[nq][2 * ks + 1][2], S[nq][2 * ks + 1][3]);
        P[nq][ks] = __builtin_bit_cast(bf16x8, u);
      }
    }
    if (!PAIR) {
      if (t + 1 < ntile) {
        A_LSTORE(p, (t + 1) & 1);
        if (t + 2 < ntile) A_GLOAD(p, t + 2);
      }
    }
    __builtin_amdgcn_s_setprio(1);
#pragma unroll
    for (int dvb = 0; dvb < NDV; ++dvb)
#pragma unroll
      for (int ks = 0; ks < 2; ++ks) {
        const bf16x8 vf = ldf(Vb0 + (dvb * 16 + l16) * 80 + ks * 32 + quad * 8);
        O[dvb][0] = mfma(vf, P[0][ks], O[dvb][0]);
        O[dvb][1] = mfma(vf, P[1][ks], O[dvb][1]);
      }
    if (PAIR) {
      if (two) {
#pragma unroll
        for (int dvb = 0; dvb < NDV; ++dvb)
#pragma unroll
          for (int ks = 0; ks < 2; ++ks) {
            const bf16x8 vf = ldf(Vb1 + (dvb * 16 + l16) * 80 + ks * 32 + quad * 8);
            O[dvb][0] = mfma(vf, P[0][NKB / 2 - 2 + ks], O[dvb][0]);
            O[dvb][1] = mfma(vf, P[1][NKB / 2 - 2 + ks], O[dvb][1]);
          }
      }
      __builtin_amdgcn_s_setprio(0);
      if (itn + 1 < niter) {
        __syncthreads();
        A_LSTORE(p, 0);
        if (t + 3 < ntile) A_LSTORE(q, 1);
        __syncthreads();
        if (t + 4 < ntile) A_GLOAD(p, t + 4);
        if (t + 5 < ntile) A_GLOAD(q, t + 5);
      }
    } else {
      __builtin_amdgcn_s_setprio(0);
      if (t + 1 < ntile) __syncthreads();
    }
  }
}
#undef A_LSTORE
#undef A_GLOAD
DI void attn_a_phase(const Params& p, char* smem, int layer) {
  const int tid = threadIdx.x, lane = tid & 63, w = tid >> 6, l16 = lane & 15, quad = lane >> 4;
  const u16* PR = (const u16*)(p.ws + OFF_PR);
  const u16* VT = (const u16*)(p.ws + OFF_VT);
  u16* OG = (u16*)(p.ws + OFF_H);
  const float* sink = p.in[lbase(layer) + 5];
  const u16* CK = (const u16*)(p.ws + (layer == 0 ? OFF_CK0 : OFF_CK3));
  const u16* CV = (const u16*)(p.ws + (layer == 0 ? OFF_CV0 : OFF_CV3));
  for (int itx0 = blockIdx.x; itx0 < 1024; itx0 += gridDim.x) {
    const bool lat = itx0 < 512;
    const int v0 = lat ? itx0 : itx0 - 512;
    const int itx = (v0 & 7) * 64 + (v0 >> 3);
    int qt, hkv, b, seq_row;
    AttnItem it;
    if (lat) {
      qt = itx & 31; hkv = (itx >> 5) & 3; b = itx >> 7; seq_row = 4096 + b * 1024;
      const int q0 = qt * 32;
      it.t_lo = (q0 >= 128 ? q0 - 128 : 0) >> 6;
      int t_hi = (q0 + 159) >> 6; if (t_hi > 15) t_hi = 15;
      it.n_loc = t_hi - it.t_lo + 1; it.mask = 1; it.n_cache = 8;
      it.kc = CK + (size_t)b * 512 * 256 + hkv * 64; it.ldkc = 256;
      it.vtc = CV + (size_t)(b * 256 + hkv * 64) * 512;
    } else {
      const int id = itx;
      qt = id & 7; hkv = (id >> 3) & 3; b = id >> 5; seq_row = b * 256;
      it.t_lo = 0; it.n_loc = 4; it.mask = 0; it.n_cache = 0; it.kc = nullptr; it.ldkc = 0; it.vtc = nullptr;
    }
    it.kb = PR + (size_t)seq_row * 2560 + 1024 + hkv * 64; it.ldk = 2560;
    it.vtb = VT + (size_t)(hkv * 64) * 8192 + seq_row;
    const int hq = hkv * 4 + w;
    bf16x8 qf[2][2];
#pragma unroll
    for (int nq = 0; nq < 2; ++nq) {
      const u16* qp = PR + (size_t)(seq_row + qt * 32 + nq * 16 + l16) * 2560 + hq * 64 + quad * 8;
      qf[nq][0] = ldf(qp); qf[nq][1] = ldf(qp + 32);
    }
    f32x4 O[4][2];
    float mrun[2], lrun[2];
    const float sk = sink[hq];
#pragma unroll
    for (int nq = 0; nq < 2; ++nq) { mrun[nq] = sk * 8.f; lrun[nq] = (quad == 0) ? 1.f : 0.f; }
#pragma unroll
    for (int d = 0; d < 4; ++d) { O[d][0] = zero4(); O[d][1] = zero4(); }
    attn_core<64, 4>(smem, it, qf, 0, qt * 32, O, mrun, lrun);
#pragma unroll
    for (int nq = 0; nq < 2; ++nq) {
      float l = lrun[nq]; l += __shfl_xor(l, 16); l += __shfl_xor(l, 32);
      const float inv = 1.f / l;
      const int row = seq_row + qt * 32 + nq * 16 + l16;
#pragma unroll
      for (int dvb = 0; dvb < 4; ++dvb) {
        const int col = hq * 64 + dvb * 16 + quad * 4;
        const uint2 zz = *reinterpret_cast<const uint2*>(PR + (size_t)row * 2560 + 1536 + col);
        const float z0 = bf2f((u16)(zz.x & 0xffff)), z1 = bf2f((u16)(zz.x >> 16)), z2 = bf2f((u16)(zz.y & 0xffff)), z3 = bf2f((u16)(zz.y >> 16));
        uint2 o;
        o.x = pack2(O[dvb][nq][0] * inv * silu(z0), O[dvb][nq][1] * inv * silu(z1));
        o.y = pack2(O[dvb][nq][2] * inv * silu(z2), O[dvb][nq][3] * inv * silu(z3));
        *reinterpret_cast<uint2*>(OG + (size_t)row * 1024 + col) = o;
      }
    }
  }
}

DI void attn_b_phase(const Params& p, char* smem) {
  const int tid = threadIdx.x, lane = tid & 63, w = tid >> 6, l16 = lane & 15, quad = lane >> 4;
  const int comp = w & 1, qh = w >> 1;
  const u16* PR = (const u16*)(p.ws + OFF_PR);
  const u16* VT = (const u16*)(p.ws + OFF_VT);
  u16* OG = (u16*)(p.ws + OFF_H);
  const float* LAM = (const float*)(p.ws + OFF_LAM);
  const float lam = LAM[0], lam_init = LAM[1];
  const float* subw = p.in[26];
  const u16* CK = (const u16*)(p.ws + OFF_CK1);
  const u16* CV = (const u16*)(p.ws + OFF_CV1);
  float4* Ox = (float4*)smem;
  for (int itx0 = blockIdx.x; itx0 < 1024; itx0 += gridDim.x) {
    const bool lat = itx0 < 512;
    const int v0 = lat ? itx0 : itx0 - 512;
    const int itx = (v0 & 7) * 64 + (v0 >> 3);
    int qt, h, b, seq_row;
    AttnItem it;
    if (lat) {
      qt = itx & 15; h = (itx >> 4) & 7; b = itx >> 7; seq_row = 4096 + b * 1024; it.n_loc = 16; it.n_cache = 8;
      it.kc = CK + (size_t)b * 512 * 1024 + h * 128; it.ldkc = 1024;
      it.vtc = CV + (size_t)(b * 1024 + h * 128) * 512;
    } else {
      const int id = itx; qt = id & 3; h = (id >> 2) & 7; b = id >> 5; seq_row = b * 256; it.n_loc = 4; it.n_cache = 0;
      it.kc = nullptr; it.ldkc = 0; it.vtc = nullptr;
    }
    it.t_lo = 0; it.mask = 0;
    it.kb = PR + (size_t)seq_row * 4096 + 1024 + h * 128; it.ldk = 4096;
    it.vtb = VT + (size_t)(h * 128) * 8192 + seq_row;
    bf16x8 qf[2][2];
#pragma unroll
    for (int nq = 0; nq < 2; ++nq) {
      const u16* qp = PR + (size_t)(seq_row + qt * 64 + qh * 32 + nq * 16 + l16) * 4096 + h * 128 + comp * 64 + quad * 8;
      qf[nq][0] = ldf(qp); qf[nq][1] = ldf(qp + 32);
    }
    f32x4 O[8][2];
    float mrun[2], lrun[2];
#pragma unroll
    for (int nq = 0; nq < 2; ++nq) { mrun[nq] = -1e30f; lrun[nq] = 0.f; }
#pragma unroll
    for (int d = 0; d < 8; ++d) { O[d][0] = zero4(); O[d][1] = zero4(); }
    attn_core<128, 8>(smem, it, qf, comp * 64, qt * 64 + qh * 32, O, mrun, lrun);
    float inv[2];
#pragma unroll
    for (int nq = 0; nq < 2; ++nq) { float l = lrun[nq]; l += __shfl_xor(l, 16); l += __shfl_xor(l, 32); inv[nq] = 1.f / l; }
    __syncthreads();
    if (comp == 1) {
#pragma unroll
      for (int d = 0; d < 8; ++d)
#pragma unroll
        for (int nq = 0; nq < 2; ++nq) {
          float4 v; v.x = O[d][nq][0] * inv[nq]; v.y = O[d][nq][1] * inv[nq]; v.z = O[d][nq][2] * inv[nq]; v.w = O[d][nq][3] * inv[nq];
          Ox[((qh * 8 + d) * 2 + nq) * 64 + lane] = v;
        }
    }
    __syncthreads();
    if (comp == 0) {
#pragma unroll
      for (int nq = 0; nq < 2; ++nq) {
        float ss = 0.f;
#pragma unroll
        for (int d = 0; d < 8; ++d) {
          const float4 o1 = Ox[((qh * 8 + d) * 2 + nq) * 64 + lane];
          const float d0 = O[d][nq][0] * inv[nq] - lam * o1.x, d1 = O[d][nq][1] * inv[nq] - lam * o1.y;
          const float d2 = O[d][nq][2] * inv[nq] - lam * o1.z, d3 = O[d][nq][3] * inv[nq] - lam * o1.w;
          O[d][nq][0] = d0; O[d][nq][1] = d1; O[d][nq][2] = d2; O[d][nq][3] = d3;
          ss += d0 * d0 + d1 * d1 + d2 * d2 + d3 * d3;
        }
        ss += __shfl_xor(ss, 16); ss += __shfl_xor(ss, 32);
        const float rs = rsqrtf(ss * (1.f / 128.f) + NORM_EPS) * (1.f - lam_init);
        const int row = seq_row + qt * 64 + qh * 32 + nq * 16 + l16;
#pragma unroll
        for (int d = 0; d < 8; ++d) {
          const int e0 = d * 16 + quad * 4;
          const int col = h * 128 + e0;
          const uint2 zz = *reinterpret_cast<const uint2*>(PR + (size_t)row * 4096 + 3072 + col);
          const float z0 = bf2f((u16)(zz.x & 0xffff)), z1 = bf2f((u16)(zz.x >> 16)), z2 = bf2f((u16)(zz.y & 0xffff)), z3 = bf2f((u16)(zz.y >> 16));
          const float4 sw = *reinterpret_cast<const float4*>(subw + e0);
          uint2 o;
          o.x = pack2(O[d][nq][0] * rs * sw.x * silu(z0), O[d][nq][1] * rs * sw.y * silu(z1));
          o.y = pack2(O[d][nq][2] * rs * sw.z * silu(z2), O[d][nq][3] * rs * sw.w * silu(z3));
          *reinterpret_cast<uint2*>(OG + (size_t)row * 1024 + col) = o;
        }
      }
    }
  }
}

DI void unpack8(const uint4 v, float (&f)[8]) {
  f[0] = bf2f((u16)(v.x & 0xffff)); f[1] = bf2f((u16)(v.x >> 16)); f[2] = bf2f((u16)(v.y & 0xffff)); f[3] = bf2f((u16)(v.y >> 16));
  f[4] = bf2f((u16)(v.z & 0xffff)); f[5] = bf2f((u16)(v.z >> 16)); f[6] = bf2f((u16)(v.w & 0xffff)); f[7] = bf2f((u16)(v.w >> 16));
}
DI void dn_conv_phase(const Params& p) {
  const int lane = threadIdx.x & 63, w = threadIdx.x >> 6, l16 = lane & 15, gsub = lane >> 4;
  const u16* PR = (const u16*)(p.ws + OFF_PR);
  const float* cw = p.in[32];
  const float* GATES = (const float*)(p.ws + OFF_GATES);
  float* GB = (float*)(p.ws + OFF_GB);
  constexpr int NCONV = 1024 * 6, NGATE = 512;
  for (int task = blockIdx.x * 4 + w; task < NCONV + NGATE; task += gridDim.x * 4) {
    if (task >= NCONV) {
      const int row0 = (task - NCONV) * 16;
      const u16* HR = (const u16*)(p.ws + OFF_HR);
      const u16* WG = (const u16*)(p.ws + OFF_WTIN + WTIN_L2) + (size_t)4096 * 1024;
      const int quad = lane >> 4;
      const u16* ap = HR + (size_t)(row0 + l16) * 1024 + quad * 8;
      const u16* bp0 = WG + (size_t)l16 * 1024 + quad * 8;
      const u16* bp1 = WG + (size_t)(16 + l16) * 1024 + quad * 8;
      f32x4 g0 = zero4(), g1 = zero4();
#pragma unroll 8
      for (int ks = 0; ks < 32; ++ks) {
        const bf16x8 a = ldf(ap + ks * 32), b0 = ldf(bp0 + ks * 32), b1 = ldf(bp1 + ks * 32);
        g0 = mfma(a, b0, g0);
        g1 = mfma(a, b1, g1);
      }
      const int cond = row0 < 4096 ? 0 : 1 + ((row0 - 4096) >> 10);
      const float* SS = (const float*)(p.ws + OFF_SS) + 2 * 8192;
      const float* SWg = (const float*)(p.ws + OFF_SW) + (size_t)(2 * 5 + cond) * 4224 + 4096;
      const float sw0 = SWg[l16], sw1 = SWg[16 + l16];
      const float dtb = p.in[34][l16], ea = expf(p.in[33][l16]);
#pragma unroll
      for (int r = 0; r < 4; ++r) {
        const int row = row0 + quad * 4 + r;
        const float rs = rsqrtf(SS[row] * (1.f / 1024.f) + NORM_EPS);
        const float raw_b = rs * g0[r] + sw0, raw_a = rs * g1[r] + sw1;
        GB[(size_t)row * 32 + l16] = 1.f / (1.f + expf(-raw_b));
        const float x = raw_a + dtb;
        const float sp = fmaxf(x, 0.f) + log1pf(expf(-fabsf(x)));
        GB[(size_t)row * 32 + 16 + l16] = -ea * sp;
      }
      continue;
    }
    const int strip = task / 6, g4 = task - strip * 6;
    const int g = g4 * 4 + gsub;
    const int r0 = strip * 8;
    int t0, L;
    if (r0 < 4096) { t0 = r0 & 255; L = 256; } else { t0 = (r0 - 4096) & 1023; L = 1024; }
    const int ch = g * 128 + l16 * 8;
    const u16* src = PR + (size_t)r0 * 4224 + ch;
    uint4 rows[10];
    const uint4 z4 = make_uint4(0u, 0u, 0u, 0u);
    rows[0] = (t0 > 0) ? ntload_u4(src - 4224) : z4;
#pragma unroll
    for (int i = 0; i < 8; ++i) rows[i + 1] = ntload_u4(src + (size_t)i * 4224);
    rows[9] = (t0 + 8 < L) ? ntload_u4(src + (size_t)8 * 4224) : z4;
    float w0[8], w1[8], w2[8];
#pragma unroll
    for (int k = 0; k < 2; ++k) {
      const float4 a = *reinterpret_cast<const float4*>(cw + ch + k * 4), b = *reinterpret_cast<const float4*>(cw + 3072 + ch + k * 4), c = *reinterpret_cast<const float4*>(cw + 6144 + ch + k * 4);
      w0[k * 4] = a.x; w0[k * 4 + 1] = a.y; w0[k * 4 + 2] = a.z; w0[k * 4 + 3] = a.w;
      w1[k * 4] = b.x; w1[k * 4 + 1] = b.y; w1[k * 4 + 2] = b.z; w1[k * 4 + 3] = b.w;
      w2[k * 4] = c.x; w2[k * 4 + 1] = c.y; w2[k * 4 + 2] = c.z; w2[k * 4 + 3] = c.w;
    }
    u16* dstb = (u16*)(p.ws + (g < 8 ? OFF_QN : (g < 16 ? OFF_KN : OFF_VV))) + (size_t)r0 * 1024 + (g & 7) * 128 + l16 * 8;
    float fm[8], f0[8], fp[8];
    unpack8(rows[0], fm); unpack8(rows[1], f0);
#pragma unroll
    for (int i = 0; i < 8; ++i) {
      unpack8(rows[i + 2], fp);
      float y[8];
      float ss = 0.f;
#pragma unroll
      for (int k = 0; k < 8; ++k) { y[k] = silu(w0[k] * fm[k] + w1[k] * f0[k] + w2[k] * fp[k]); ss += y[k] * y[k]; }
      if (g < 16) {
        ss = grp16_sum(ss);
        float sc = rsqrtf(ss + 1e-6f);
        if (g < 8) sc *= 0.08838834764831845f;
#pragma unroll
        for (int k = 0; k < 8; ++k) y[k] *= sc;
      }
      uint4 o; o.x = pack2(y[0], y[1]); o.y = pack2(y[2], y[3]); o.z = pack2(y[4], y[5]); o.w = pack2(y[6], y[7]);
      *reinterpret_cast<uint4*>(dstb + (size_t)i * 1024) = o;
#pragma unroll
      for (int k = 0; k < 8; ++k) { fm[k] = f0[k]; f0[k] = fp[k]; }
    }
  }
}

struct SeqInfo { int base_row, L, nc, gc_base; };
DI SeqInfo seq_info(int seq) {
  SeqInfo s;
  if (seq < 16) { s.base_row = seq * 256; s.L = 256; s.nc = 4; s.gc_base = seq * 4; }
  else { s.base_row = 4096 + (seq - 16) * 1024; s.L = 1024; s.nc = 16; s.gc_base = 64 + (seq - 16) * 16; }
  return s;
}

DI void dn_chunk_phase(const Params& p, char* smem) {
  const int lane = threadIdx.x & 63, w = threadIdx.x >> 6, l16 = lane & 15, quad = lane >> 4;
  float* Lw = (float*)smem + w * (64 * 68);
  const u16* KN = (const u16*)(p.ws + OFF_KN);
  const float* GB = (const float*)(p.ws + OFF_GB);
  u16* TM = (u16*)(p.ws + OFF_TM);
  for (int tk = blockIdx.x * 4 + w; tk < 2048; tk += gridDim.x * 4) {
    const int dir = tk & 1, h = (tk >> 1) & 7, gc = tk >> 4;
    int base_row, L, c;
    if (gc < 64) { base_row = (gc >> 2) * 256; L = 256; c = gc & 3; }
    else { const int lc = gc - 64; base_row = 4096 + (lc >> 4) * 1024; L = 1024; c = lc & 15; }
    const int p0 = c * 64;
    const int tok_i = base_row + (dir ? (L - 1 - (p0 + lane)) : (p0 + lane));
    const float beta_i = GB[(size_t)tok_i * 32 + dir * 8 + h];
    float gcum = GB[(size_t)tok_i * 32 + 16 + dir * 8 + h];
#pragma unroll
    for (int o = 1; o < 64; o <<= 1) { float t = __shfl_up(gcum, o); if (lane >= o) gcum += t; }
    bf16x8 f[4][4];
#pragma unroll
    for (int mb = 0; mb < 4; ++mb) {
      const int pi = p0 + mb * 16 + l16;
      const int tok = base_row + (dir ? (L - 1 - pi) : pi);
#pragma unroll
      for (int ks = 0; ks < 4; ++ks) f[mb][ks] = ldf(KN + (size_t)tok * 1024 + h * 128 + ks * 32 + quad * 8);
    }
#pragma unroll
    for (int mb = 0; mb < 4; ++mb)
#pragma unroll
      for (int nb = 0; nb <= mb; ++nb) {
        f32x4 a = zero4();
#pragma unroll
        for (int ks = 0; ks < 4; ++ks) a = mfma(f[mb][ks], f[nb][ks], a);
        const int jj = nb * 16 + l16;
        const float gj = __shfl(gcum, jj);
#pragma unroll
        for (int j = 0; j < 4; ++j) {
          const int i = mb * 16 + quad * 4 + j;
          const float gi = __shfl(gcum, i), bi = __shfl(beta_i, i);
          Lw[i * 68 + jj] = (i > jj) ? bi * a[j] * __expf(gi - gj) : 0.f;
        }
      }
    __builtin_amdgcn_fence(__ATOMIC_RELEASE, "wavefront");
    __builtin_amdgcn_s_waitcnt(0xc07f);
    __builtin_amdgcn_wave_barrier();
    float t[64];
    u16* Tout = TM + (size_t)((dir * 8 + h) * 128 + gc) * 4096;
#pragma unroll
    for (int i = 0; i < 64; ++i) {
      float a = (i == lane) ? 1.f : 0.f;
#pragma unroll
      for (int j4 = 0; j4 < (i + 3) / 4; ++j4) {
        const float4 lv = *reinterpret_cast<const float4*>(Lw + i * 68 + j4 * 4);
        if (j4 * 4 + 0 < i) a -= lv.x * t[j4 * 4 + 0];
        if (j4 * 4 + 1 < i) a -= lv.y * t[j4 * 4 + 1];
        if (j4 * 4 + 2 < i) a -= lv.z * t[j4 * 4 + 2];
        if (j4 * 4 + 3 < i) a -= lv.w * t[j4 * 4 + 3];
      }
      t[i] = a;
      Tout[i * 64 + lane] = f2bf(a);
    }
    __builtin_amdgcn_wave_barrier();
  }
}

DI void dn_scan_task(const Params& p, char* smem, int seq, int h, int dir, int slice) {
  const int tid = threadIdx.x, lane = tid & 63, w = tid >> 6, l16 = lane & 15, quad = lane >> 4;
  u16* Ks = (u16*)smem;
  u16* Sb = Ks + 2 * 64 * 136;
  u16* Rt = Sb + 32 * 136;
  u16* Vn = Rt + 32 * 80;
  u16* Vs = Vn + 32 * 80;
  u16* Pl = Vs + 32 * 80;
  float* sg = (float*)(Pl + 64 * 80);
  float* sbt = sg + 128;
  const u16* QN = (const u16*)(p.ws + OFF_QN);
  const u16* KN = (const u16*)(p.ws + OFF_KN);
  const u16* VV = (const u16*)(p.ws + OFF_VV);
  const float* GB = (const float*)(p.ws + OFF_GB);
  const u16* TM = (const u16*)(p.ws + OFF_TM);
  u16* OFB = (u16*)(p.ws + OFF_OFB) + (size_t)dir * 8192 * 1024;
  const SeqInfo si = seq_info(seq);
  f32x4 Sacc[2][2];
  if (seq >= 16) {
    const float* s0 = p.in[6] + (size_t)(((seq - 16) * 2 + dir) * 8 + h) * 16384;
#pragma unroll
    for (int mb2 = 0; mb2 < 2; ++mb2)
#pragma unroll
      for (int nb = 0; nb < 2; ++nb)
#pragma unroll
        for (int j = 0; j < 4; ++j) Sacc[mb2][nb][j] = s0[(size_t)(32 * w + mb2 * 16 + quad * 4 + j) * 128 + slice * 32 + nb * 16 + l16];
  } else {
#pragma unroll
    for (int mb2 = 0; mb2 < 2; ++mb2)
#pragma unroll
      for (int nb = 0; nb < 2; ++nb) Sacc[mb2][nb] = zero4();
  }
  __syncthreads();
#pragma unroll
  for (int mb2 = 0; mb2 < 2; ++mb2)
#pragma unroll
    for (int nb = 0; nb < 2; ++nb) {
      uint2 pk; pk.x = pack2(Sacc[mb2][nb][0], Sacc[mb2][nb][1]); pk.y = pack2(Sacc[mb2][nb][2], Sacc[mb2][nb][3]);
      *reinterpret_cast<uint2*>(Sb + (nb * 16 + l16) * 136 + 32 * w + mb2 * 16 + quad * 4) = pk;
    }
  uint4 nk0, nk1, nk2, nk3; float ngr = 0.f, nbe = 0.f; bf16x8 nq0, nq1, nq2, nq3, nt0, nt1; u16 nv[2][4];
  const int krow = lane, kdc0 = 4 * w;
#define SCAN_TOK(pi_) (si.base_row + (dir ? (si.L - 1 - (pi_)) : (pi_)))
#define SCAN_FETCH(c_) do { \
    const int q0_ = (c_) * 64; \
    { const u16* kp_ = KN + (size_t)SCAN_TOK(q0_ + krow) * 1024 + h * 128 + kdc0 * 8; \
      nk0 = *reinterpret_cast<const uint4*>(kp_); nk1 = *reinterpret_cast<const uint4*>(kp_ + 8); \
      nk2 = *reinterpret_cast<const uint4*>(kp_ + 16); nk3 = *reinterpret_cast<const uint4*>(kp_ + 24); } \
    if (w == 0) { const int tk_ = SCAN_TOK(q0_ + lane); ngr = GB[(size_t)tk_ * 32 + 16 + dir * 8 + h]; nbe = GB[(size_t)tk_ * 32 + dir * 8 + h]; } \
    { const u16* qp_ = QN + (size_t)SCAN_TOK(q0_ + 16 * w + l16) * 1024 + h * 128 + quad * 8; \
      nq0 = ldf(qp_); nq1 = ldf(qp_ + 32); nq2 = ldf(qp_ + 64); nq3 = ldf(qp_ + 96); } \
    { const u16* tp_ = TM + (size_t)((dir * 8 + h) * 128 + si.gc_base + (c_)) * 4096 + (16 * w + l16) * 64 + quad * 8; \
      nt0 = ldf(tp_); nt1 = ldf(tp_ + 32); } \
    _Pragma("unroll") for (int j = 0; j < 4; ++j) { \
      const u16* vp_ = VV + (size_t)SCAN_TOK(q0_ + 16 * w + quad * 4 + j) * 1024 + h * 128 + slice * 32 + l16; \
      nv[0][j] = vp_[0]; nv[1][j] = vp_[16]; } \
  } while (0)
#define SCAN_KST(v_, i_, b_) do { \
    *reinterpret_cast<uint4*>(Ks + (b_) * 8704 + krow * 136 + (kdc0 + (i_)) * 8) = v_; \
  } while (0)
#define SCAN_STAGE(b_) do { \
    SCAN_KST(nk0, 0, b_); SCAN_KST(nk1, 1, b_); SCAN_KST(nk2, 2, b_); SCAN_KST(nk3, 3, b_); \
    if (w == 0) { \
      float gcum_ = ngr; \
      _Pragma("unroll") for (int o = 1; o < 64; o <<= 1) { float t_ = __shfl_up(gcum_, o); if (lane >= o) gcum_ += t_; } \
      sg[(b_) * 64 + lane] = gcum_; \
      sbt[(b_) * 64 + lane] = nbe; \
    } \
  } while (0)
  SCAN_FETCH(0);
  SCAN_STAGE(0);
  for (int c = 0; c < si.nc; ++c) {
    __syncthreads();
    const int p0 = c * 64;
    const u16* Kc = Ks + (c & 1) * 8704;
    const float* sgc = sg + (c & 1) * 64;
    const float* sbc = sbt + (c & 1) * 64;
    bf16x8 qf[4], tf[2];
    qf[0] = nq0; qf[1] = nq1; qf[2] = nq2; qf[3] = nq3; tf[0] = nt0; tf[1] = nt1;
    float vv[2][4];
#pragma unroll
    for (int j = 0; j < 4; ++j) { vv[0][j] = bf2f(nv[0][j]); vv[1][j] = bf2f(nv[1][j]); }
    if (c + 1 < si.nc) SCAN_FETCH(c + 1);
    f32x4 QS[2], KS[2];
#pragma unroll
    for (int nb = 0; nb < 2; ++nb) { QS[nb] = zero4(); KS[nb] = zero4(); }
#pragma unroll
    for (int ks = 0; ks < 4; ++ks) {
      const bf16x8 kfr = ldf(Kc + (16 * w + l16) * 136 + ks * 32 + quad * 8);
#pragma unroll
      for (int nb = 0; nb < 2; ++nb) {
        bf16x8 sf = ldf(Sb + (nb * 16 + l16) * 136 + ks * 32 + quad * 8);
        QS[nb] = mfma(qf[ks], sf, QS[nb]);
        KS[nb] = mfma(kfr, sf, KS[nb]);
      }
    }
    float gi[4], bi[4], egi[4];
    const float glast = sgc[63];
#pragma unroll
    for (int j = 0; j < 4; ++j) { gi[j] = sgc[16 * w + quad * 4 + j]; bi[j] = sbc[16 * w + quad * 4 + j]; egi[j] = __expf(gi[j]); }
#pragma unroll
    for (int nb = 0; nb < 2; ++nb) {
      float r0 = bi[0] * (vv[nb][0] - egi[0] * KS[nb][0]);
      float r1 = bi[1] * (vv[nb][1] - egi[1] * KS[nb][1]);
      float r2 = bi[2] * (vv[nb][2] - egi[2] * KS[nb][2]);
      float r3 = bi[3] * (vv[nb][3] - egi[3] * KS[nb][3]);
      uint2 pk; pk.x = pack2(r0, r1); pk.y = pack2(r2, r3);
      *reinterpret_cast<uint2*>(Rt + (nb * 16 + l16) * 80 + 16 * w + quad * 4) = pk;
    }
    bf16x8 Pf[2];
    {
      const int icol = 16 * w + l16;
      const float gic = sgc[icol];
      f32x4 pt[4];
#pragma unroll
      for (int nb4 = 0; nb4 < 4; ++nb4) {
        pt[nb4] = zero4();
        if (nb4 <= w) {
#pragma unroll
          for (int ks = 0; ks < 4; ++ks) pt[nb4] = mfma(ldf(Kc + (nb4 * 16 + l16) * 136 + ks * 32 + quad * 8), qf[ks], pt[nb4]);
        }
        const float4 gj4 = *reinterpret_cast<const float4*>(sgc + nb4 * 16 + quad * 4);
        const int jj0 = nb4 * 16 + quad * 4;
        pt[nb4][0] = (nb4 <= w && icol >= jj0 + 0) ? pt[nb4][0] * __expf(gic - gj4.x) : 0.f;
        pt[nb4][1] = (nb4 <= w && icol >= jj0 + 1) ? pt[nb4][1] * __expf(gic - gj4.y) : 0.f;
        pt[nb4][2] = (nb4 <= w && icol >= jj0 + 2) ? pt[nb4][2] * __expf(gic - gj4.z) : 0.f;
        pt[nb4][3] = (nb4 <= w && icol >= jj0 + 3) ? pt[nb4][3] * __expf(gic - gj4.w) : 0.f;
      }
#pragma unroll
      for (int k2 = 0; k2 < 2; ++k2) {
        uint4 u;
        u.x = pack2(pt[2 * k2][0], pt[2 * k2][1]); u.y = pack2(pt[2 * k2][2], pt[2 * k2][3]);
        u.z = pack2(pt[2 * k2 + 1][0], pt[2 * k2 + 1][1]); u.w = pack2(pt[2 * k2 + 1][2], pt[2 * k2 + 1][3]);
        Pf[k2] = __builtin_bit_cast(bf16x8, u);
      }
    }
    __syncthreads();
    f32x4 VN[2];
#pragma unroll
    for (int nb = 0; nb < 2; ++nb) {
      VN[nb] = zero4();
#pragma unroll
      for (int k2 = 0; k2 < 2; ++k2) VN[nb] = mfma(tf[k2], ldf(Rt + (nb * 16 + l16) * 80 + k2 * 32 + quad * 8), VN[nb]);
      uint2 pk, ps;
      pk.x = pack2(VN[nb][0], VN[nb][1]); pk.y = pack2(VN[nb][2], VN[nb][3]);
      ps.x = pack2(VN[nb][0] * __expf(glast - gi[0]), VN[nb][1] * __expf(glast - gi[1]));
      ps.y = pack2(VN[nb][2] * __expf(glast - gi[2]), VN[nb][3] * __expf(glast - gi[3]));
      *reinterpret_cast<uint2*>(Vn + (nb * 16 + l16) * 80 + (w >> 1) * 32 + quad * 8 + (w & 1) * 4) = pk;
      *reinterpret_cast<uint2*>(Vs + (nb * 16 + l16) * 80 + 16 * w + quad * 4) = ps;
    }
    __syncthreads();
#pragma unroll
    for (int nb = 0; nb < 2; ++nb) {
      f32x4 oi = zero4();
#pragma unroll
      for (int k2 = 0; k2 < 2; ++k2)
        oi = mfma(Pf[k2], ldf(Vn + (nb * 16 + l16) * 80 + k2 * 32 + quad * 8), oi);
#pragma unroll
      for (int j = 0; j < 4; ++j) {
        const int pi = p0 + 16 * w + quad * 4 + j;
        const int tok = si.base_row + (dir ? (si.L - 1 - pi) : pi);
        OFB[(size_t)tok * 1024 + h * 128 + slice * 32 + nb * 16 + l16] = f2bf(egi[j] * QS[nb][j] + oi[j]);
      }
    }
    const float eg = __expf(glast);
    bf16x8 ktf[2][2];
    {
      typedef short s16x4_t __attribute__((ext_vector_type(4)));
      const unsigned kta = (unsigned)(size_t)(Kc + (quad * 8 + (l16 >> 2)) * 136 + 32 * w + 4 * (l16 & 3));
      s16x4_t t00l, t00h, t01l, t01h, t10l, t10h, t11l, t11h;
      asm volatile(
          "ds_read_b64_tr_b16 %0, %8\n\t"
          "ds_read_b64_tr_b16 %1, %8 offset:1088\n\t"
          "ds_read_b64_tr_b16 %2, %8 offset:8704\n\t"
          "ds_read_b64_tr_b16 %3, %8 offset:9792\n\t"
          "ds_read_b64_tr_b16 %4, %8 offset:32\n\t"
          "ds_read_b64_tr_b16 %5, %8 offset:1120\n\t"
          "ds_read_b64_tr_b16 %6, %8 offset:8736\n\t"
          "ds_read_b64_tr_b16 %7, %8 offset:9824\n\t"
          "s_waitcnt lgkmcnt(0)"
          : "=&v"(t00l), "=&v"(t00h), "=&v"(t01l), "=&v"(t01h), "=&v"(t10l), "=&v"(t10h), "=&v"(t11l), "=&v"(t11h)
          : "v"(kta) : "memory");
      ktf[0][0] = __builtin_shufflevector(t00l, t00h, 0, 1, 2, 3, 4, 5, 6, 7);
      ktf[0][1] = __builtin_shufflevector(t01l, t01h, 0, 1, 2, 3, 4, 5, 6, 7);
      ktf[1][0] = __builtin_shufflevector(t10l, t10h, 0, 1, 2, 3, 4, 5, 6, 7);
      ktf[1][1] = __builtin_shufflevector(t11l, t11h, 0, 1, 2, 3, 4, 5, 6, 7);
    }
#pragma unroll
    for (int mb2 = 0; mb2 < 2; ++mb2)
#pragma unroll
      for (int nb = 0; nb < 2; ++nb) {
        f32x4 a = Sacc[mb2][nb];
        a[0] *= eg; a[1] *= eg; a[2] *= eg; a[3] *= eg;
#pragma unroll
        for (int k2 = 0; k2 < 2; ++k2)
          a = mfma(ktf[mb2][k2], ldf(Vs + (nb * 16 + l16) * 80 + k2 * 32 + quad * 8), a);
        Sacc[mb2][nb] = a;
        uint2 pk; pk.x = pack2(a[0], a[1]); pk.y = pack2(a[2], a[3]);
        *reinterpret_cast<uint2*>(Sb + (nb * 16 + l16) * 136 + 32 * w + mb2 * 16 + quad * 4) = pk;
      }
    if (c + 1 < si.nc) SCAN_STAGE((c + 1) & 1);
  }
  if (seq < 16) {
    float* so = p.out + OUT_L2S + (size_t)((seq * 2 + dir) * 8 + h) * 16384;
#pragma unroll
    for (int mb2 = 0; mb2 < 2; ++mb2)
#pragma unroll
      for (int nb = 0; nb < 2; ++nb)
#pragma unroll
        for (int j = 0; j < 4; ++j) __builtin_nontemporal_store(Sacc[mb2][nb][j], so + (size_t)(32 * w + mb2 * 16 + quad * 4 + j) * 128 + slice * 32 + nb * 16 + l16);
  }
}

#undef SCAN_TOK
#undef SCAN_FETCH
#undef SCAN_KST
#undef SCAN_STAGE
DI void dn_scan_phase(const Params& p, char* smem) {
  for (int unit = blockIdx.x; unit < 512; unit += gridDim.x) {
    const int ntask = unit < 256 ? 1 : 4;
    for (int q = 0; q < ntask; ++q) {
      int seq, code;
      if (unit < 256) { const int u = (unit & 7) * 32 + (unit >> 3); seq = 16 + (u >> 6); code = u & 63; }
      else { const int u0 = unit - 256; const int u = (u0 & 7) * 32 + (u0 >> 3); const int ct = u * 4 + q; seq = ct >> 6; code = ct & 63; }
      dn_scan_task(p, smem, seq, (code >> 3) & 7, (code >> 2) & 1, code & 3);
    }
  }
}

DI void dn_out_phase(const Params& p) {
  const int lane = threadIdx.x & 63, w = threadIdx.x >> 6, l16 = lane & 15, hs = lane >> 4;
  const u16* OF = (const u16*)(p.ws + OFF_OFB);
  const u16* OB = OF + (size_t)8192 * 1024;
  const u16* PR = (const u16*)(p.ws + OFF_PR);
  u16* OG = (u16*)(p.ws + OFF_H);
  float gw[8];
  {
    const float4 a = *reinterpret_cast<const float4*>(p.in[35] + l16 * 8), b = *reinterpret_cast<const float4*>(p.in[35] + l16 * 8 + 4);
    gw[0] = a.x; gw[1] = a.y; gw[2] = a.z; gw[3] = a.w; gw[4] = b.x; gw[5] = b.y; gw[6] = b.z; gw[7] = b.w;
  }
  for (int task = blockIdx.x * 4 + w; task < 4096; task += gridDim.x * 4) {
    uint4 a[4], b[4], z[4];
#pragma unroll
    for (int u = 0; u < 4; ++u) {
      const int r = task * 2 + (u >> 1), h = (u & 1) * 4 + hs;
      const size_t off = (size_t)r * 1024 + h * 128 + l16 * 8;
      a[u] = ntload_u4(OF + off);
      b[u] = ntload_u4(OB + off);
      z[u] = ntload_u4(PR + (size_t)r * 4224 + 3072 + h * 128 + l16 * 8);
    }
#pragma unroll
    for (int u = 0; u < 4; ++u) {
      const int r = task * 2 + (u >> 1), h = (u & 1) * 4 + hs;
      float fa[8], fb[8], fz[8];
      unpack8(a[u], fa); unpack8(b[u], fb); unpack8(z[u], fz);
      float ss = 0.f;
#pragma unroll
      for (int k = 0; k < 8; ++k) { fa[k] += fb[k]; ss += fa[k] * fa[k]; }
      ss = grp16_sum(ss);
      const float rs = rsqrtf(ss * (1.f / 128.f) + NORM_EPS);
#pragma unroll
      for (int k = 0; k < 8; ++k) fa[k] = fa[k] * rs * gw[k] * silu(fz[k]);
      uint4 o; o.x = pack2(fa[0], fa[1]); o.y = pack2(fa[2], fa[3]); o.z = pack2(fa[4], fa[5]); o.w = pack2(fa[6], fa[7]);
      *reinterpret_cast<uint4*>(OG + (size_t)r * 1024 + h * 128 + l16 * 8) = o;
    }
  }
}

#define XB_TMO      128
#define XB_XCNT(j)  (256  + 64 * (j))
#define XB_XSUB(j)  (1280 + 64 * (j))
#define XB_XGEN(j)  (2304 + 64 * (j))
#define XB_TOP      3328
#define XB_TOPGEN   3392
#define XCD_BAR_WORDS 3456
#define XB_SPIN_CAP (1u << 20)
#define LAS __attribute__((address_space(3)))
DI unsigned xb_ld(unsigned* p)              { return __hip_atomic_load(p, __ATOMIC_RELAXED, __HIP_MEMORY_SCOPE_AGENT); }
DI unsigned xb_add(unsigned* p, unsigned v) { return __hip_atomic_fetch_add(p, v, __ATOMIC_RELAXED, __HIP_MEMORY_SCOPE_AGENT); }
DI unsigned xb_xcc_id() { return (unsigned)__builtin_amdgcn_s_getreg((3 << 11) | 20) & 0xFu; }
#define XB_SPIN(cond, bar) do { unsigned _sp = 0; while (cond) { __builtin_amdgcn_s_sleep(1); \
    if ((++_sp & 255u) == 0u) { if (xb_ld(&(bar)[XB_TMO])) break; if (_sp > XB_SPIN_CAP) { atomicAdd(&(bar)[XB_TMO], 1u); break; } } } } while (0)
struct XcdBarrier { unsigned* bar; unsigned x; volatile LAS unsigned* st; };
DI XcdBarrier xcd_barrier_post(unsigned* bar, volatile LAS unsigned* st) {
  XcdBarrier b; b.bar = bar; b.x = xb_xcc_id(); b.st = st;
  if (threadIdx.x == 0) (void)xb_add(&bar[XB_XCNT(b.x)], 1u);
  return b;
}
DI void xcd_barrier_complete(unsigned* bar, unsigned x, unsigned& nloc, unsigned& nx) {
  const unsigned G = gridDim.x * gridDim.y * gridDim.z;
  unsigned sum, cnt, mine, sp = 0u;
  for (;;) {
    sum = 0u; cnt = 0u; mine = 0u;
#pragma unroll
    for (unsigned j = 0; j < 16; ++j) { const unsigned c = xb_ld(&bar[XB_XCNT(j)]); sum += c; cnt += (c > 0u) ? 1u : 0u; mine = (j == x) ? c : mine; }
    if (sum == G) break;
    __builtin_amdgcn_s_sleep(1);
    if ((++sp & 255u) == 0u) { if (xb_ld(&bar[XB_TMO])) break; if (sp > XB_SPIN_CAP) { atomicAdd(&bar[XB_TMO], 1u); break; } }
  }
  nloc = mine > 0u ? mine : 1u; nx = cnt > 0u ? cnt : 1u;
}
DI void xcd_barrier(const XcdBarrier& b) {
  asm volatile("s_waitcnt vmcnt(0)" ::: "memory");
  __syncthreads();
  if (threadIdx.x == 0) {
    unsigned* bar = b.bar;
    __builtin_amdgcn_s_waitcnt(0);
    unsigned nloc = b.st[0], nx = b.st[1];
    if (nloc == 0u) { xcd_barrier_complete(bar, b.x, nloc, nx); b.st[0] = nloc; b.st[1] = nx; }
    const unsigned old = xb_add(&bar[XB_XSUB(b.x)], 1u);
    const unsigned gen = old / nloc;
    if (old + 1u == (gen + 1u) * nloc) {
      __builtin_amdgcn_fence(__ATOMIC_RELEASE, "agent");
      asm volatile("s_waitcnt vmcnt(0)" ::: "memory");
      const unsigned og = xb_add(&bar[XB_TOP], 1u);
      const unsigned tg = og / nx;
      if (og + 1u == (tg + 1u) * nx) xb_add(&bar[XB_TOPGEN], 1u);
      else XB_SPIN(xb_ld(&bar[XB_TOPGEN]) == tg, bar);
      __builtin_amdgcn_fence(__ATOMIC_ACQUIRE, "agent");
      xb_add(&bar[XB_XGEN(b.x)], 1u);
      asm volatile("s_waitcnt vmcnt(0)" ::: "memory");
    } else {
      XB_SPIN(xb_ld(&bar[XB_XGEN(b.x)]) == gen, bar);
      __builtin_amdgcn_fence(__ATOMIC_ACQUIRE, "agent");
      asm volatile("s_waitcnt vmcnt(0)" ::: "memory");
    }
  }
  __syncthreads();
}

DI void gemm_for(const Params& p, char* smem, int layer, int which) {
  const u16* H = (const u16*)(p.ws + OFF_H);
  EpiArgs e;
  const u16* WT;
  int ntn;
  e.layer = layer;
  if (which >= 1) {
    e.kind = which == 1 ? 2 : 3; e.ld = 0; e.rope_end = 0; e.k_beg = 0; e.k_end = 0; e.v_end = 0; e.kw = 0; e.outk = nullptr; e.outv = nullptr;
    WT = (const u16*)(p.ws + OFF_WTOUT + (size_t)layer * 2097152); ntn = 8;
  } else if (layer == 1) {
    e.kind = 0; e.ld = 4096; e.rope_end = 2048; e.k_beg = 1024; e.k_end = 2048; e.v_end = 3072; e.kw = 1024;
    e.outk = p.out + OUT_L1K; e.outv = p.out + OUT_L1V;
    WT = (const u16*)(p.ws + OFF_WTIN + WTIN_L1); ntn = 32;
  } else if (layer == 2) {
    e.kind = 1; e.ld = 4224; e.rope_end = 0; e.k_beg = 0; e.k_end = 0; e.v_end = 0; e.kw = 0; e.outk = nullptr; e.outv = nullptr;
    WT = (const u16*)(p.ws + OFF_WTIN + WTIN_L2); ntn = 32;
  } else {
    e.kind = 0; e.ld = 2560; e.rope_end = 1280; e.k_beg = 1024; e.k_end = 1280; e.v_end = 1536; e.kw = 256;
    e.outk = p.out + (layer == 0 ? OUT_L0K : OUT_L3K); e.outv = p.out + (layer == 0 ? OUT_L0V : OUT_L3V);
    WT = (const u16*)(p.ws + OFF_WTIN + (layer == 0 ? WTIN_L0 : WTIN_L3)); ntn = 20;
  }
  e.fused = (which == 0) ? (layer >= 1) : (which == 1 && layer < 3);
  const u16* A = (which == 0 && layer >= 1) ? (const u16*)(p.ws + OFF_HR) : H;
  gemm_phase(p, smem, A, WT, ntn, e);
}

constexpr int NPHASE = 30;
DI void run_phase(const Params& p, char* smem, int ph) {
  if (ph == 0) { phase0(p, smem); return; }
  if (ph == 29) { norm_phase(p, 4); return; }
  const int l = (ph - 1) / 7, s = (ph - 1) % 7;
  if (s == 0) norm_phase(p, l);
  else if (s == 1) gemm_for(p, smem, l, 0);
  else if (s == 6) gemm_for(p, smem, l, 1);
  else if (l == 2) {
    if (s == 2) dn_conv_phase(p);
    else if (s == 3) dn_chunk_phase(p, smem);
    else if (s == 4) dn_scan_phase(p, smem);
    else dn_out_phase(p);
  } else if (s == 2) {
    if (l == 1) attn_b_phase(p, smem); else attn_a_phase(p, smem, l);
  }
}
DI bool phase_empty(int ph) {
  if (ph == 0 || ph == 29) return false;
  const int l = (ph - 1) / 7, s = (ph - 1) % 7;
  return (l != 2) && (s >= 3 && s <= 5);
}

#if ONE_LAUNCH
__global__ void __launch_bounds__(256, 2) mega_kernel(Params p) {
  __shared__ __attribute__((aligned(16))) char smem[SMEM_BYTES];
  cg::grid_group grid = cg::this_grid();
  __shared__ uint4 xb_words;
  if (threadIdx.x == 0) xb_words = make_uint4(0u, 0u, 0u, 0u);
  __syncthreads();
  XcdBarrier xb = xcd_barrier_post((unsigned*)(p.ws + OFF_BAR), (volatile LAS unsigned*)&xb_words);
  if (p.ws == nullptr) grid.sync();
#define REP_0(x) x;
#define REP_1(x) x; x;
#define REP_I(n, x) REP_##n(x)
#define REP(n, x) REP_I(n, x)
#define GSYNC REP(DUP_SYNC, xcd_barrier(xb))
  REP(DUP_P0, phase0(p, smem)) GSYNC;
  REP(DUP_NORM, norm_phase(p, 0)) sw_tasks(p); GSYNC;
  REP(DUP_GEMM, gemm_for(p, smem, 0, 0)) GSYNC;
  REP(DUP_ATT, attn_a_phase(p, smem, 0)) GSYNC;
  gemm_for(p, smem, 0, 1);
#if DUP_OUT
  gemm_for(p, smem, 0, 2);
#endif
  GSYNC;
  REP(DUP_GEMM, gemm_for(p, smem, 1, 0)) GSYNC;
  REP(DUP_DN2, attn_b_phase(p, smem)) GSYNC;
  gemm_for(p, smem, 1, 1);
#if DUP_OUT
  gemm_for(p, smem, 1, 2);
#endif
  GSYNC;
  REP(DUP_GEMM, gemm_for(p, smem, 2, 0)) GSYNC;
  REP(DUP_DN, dn_conv_phase(p)) GSYNC;
  REP(DUP_DN, dn_chunk_phase(p, smem)) GSYNC;
  REP(DUP_DN, dn_scan_phase(p, smem)) GSYNC;
  REP(DUP_DN, dn_out_phase(p)) GSYNC;
  gemm_for(p, smem, 2, 1);
#if DUP_OUT
  gemm_for(p, smem, 2, 2);
#endif
  GSYNC;
  REP(DUP_GEMM, gemm_for(p, smem, 3, 0)) GSYNC;
  REP(DUP_ATT, attn_a_phase(p, smem, 3)) GSYNC;
  gemm_for(p, smem, 3, 1);
#if DUP_OUT
  gemm_for(p, smem, 3, 2);
#endif
  GSYNC;
  REP(DUP_NORM, norm_phase(p, 4))
}
#else
__global__ void __launch_bounds__(256, 2) phase_kernel(Params p, int ph) {
  __shared__ __attribute__((aligned(16))) char smem[SMEM_BYTES];
  run_phase(p, smem, ph);
}
#endif

extern "C" void kernel_launch(void* const* d_in, const int* in_sizes, int n_in, void* d_out, int out_size, void* d_ws, size_t ws_size,
                              hipStream_t stream) {
  if (n_in != 43 || ws_size < WS_END) { fprintf(stderr, "kernel_launch: unexpected n_in %d / ws_size %zu\n", n_in, ws_size); return; }
  Params p{};
  for (int i = 0; i < 43; ++i) p.in[i] = (const float*)d_in[i];
  p.out = (float*)d_out;
  p.ws = (char*)d_ws;
#if ONE_LAUNCH
  static int grid_blocks = 0;
  if (!grid_blocks) {
    int dev = 0, cus = 0, per_cu = 0;
    hipGetDevice(&dev);
    hipDeviceGetAttribute(&cus, hipDeviceAttributeMultiprocessorCount, dev);
    hipOccupancyMaxActiveBlocksPerMultiprocessor(&per_cu, mega_kernel, 256, 0);
    if (per_cu < 1) per_cu = 1;
    if (per_cu > 2) per_cu = 2;
    grid_blocks = cus * per_cu;
  }
  (void)hipMemsetAsync((char*)d_ws + OFF_BAR, 0, 16384, stream);
  void* args[] = {&p};
  hipError_t e = hipLaunchCooperativeKernel((void*)mega_kernel, dim3(grid_blocks), dim3(256), args, 0, stream);
  if (e != hipSuccess) fprintf(stderr, "cooperative launch failed: %s (grid %d)\n", hipGetErrorString(e), grid_blocks);
#else
  for (int ph = 0; ph < NPHASE; ++ph) { bool empty = (ph != 0 && ph != 29) && ((ph - 1) / 7 != 2) && ((ph - 1) % 7 >= 3 && (ph - 1) % 7 <= 5); if (!empty) phase_kernel<<<512, 256, 0, stream>>>(p, ph); }
#endif
}
```
